# Optimizing an MI355X kernel written in HIP

```python
import jax, jax.numpy as jnp
from jax import lax
import numpy as np

D_MODEL = 1024
BATCH = 32
SEQ = 256
DEPTH = 1
DEC_BATCH = 4
DEC_SEQ = 2048
PAST_LEN = 256

GRID_W = 64
GLA_WIDTH = 512
GLA_HEADS = 4
GLA_DK = 64
GLA_DV = 128
QK_W = GLA_HEADS * GLA_DK
GLA_LOWRANK = 16
GLA_TAU = 16.0
GLA_CHUNK = 64
CONV_WIDTH = 512
CONV_K = 3
MIX_WIDTH = GLA_WIDTH + CONV_WIDTH
D_FF = 2816
N_MOD = 9
EPS = 1e-6
SPLITS = [QK_W, QK_W, GLA_WIDTH, GLA_WIDTH, GLA_LOWRANK, GLA_LOWRANK, CONV_WIDTH, CONV_WIDTH, CONV_WIDTH]
IN_COLS = sum(SPLITS)
SPLIT_IDX = list(np.cumsum(SPLITS)[:-1])

kernel_name = "hybrid_gla_shortconv_diffusion_step"


def rmsnorm(x, g):
    xf = x.astype(jnp.float32)
    y = xf * lax.rsqrt(jnp.mean(xf * xf, axis=-1, keepdims=True) + EPS)
    return (y * g.astype(jnp.float32)).astype(x.dtype)


def ada_mod(cvec, w, b):
    return (jax.nn.silu(cvec) @ w + b).reshape(cvec.shape[0], N_MOD, D_MODEL)


def swiglu(h, w1, w3, w2):
    return (jax.nn.silu(h @ w1) * (h @ w3)) @ w2


def conv3_centred(u, w):
    up = jnp.pad(u, [(0, 0)] * (u.ndim - 2) + [(1, 1), (0, 0)])
    return w[0] * up[..., :-2, :] + w[1] * up[..., 1:-1, :] + w[2] * up[..., 2:, :]


def gla_chunked(q, k, v, log_a, s0):
    b, h, l, _ = q.shape
    dv = v.shape[-1]
    n = l // GLA_CHUNK

    def to_chunks(t):
        return jnp.moveaxis(t.reshape(b, h, n, GLA_CHUNK, t.shape[-1]), 2, 0)

    mask = jnp.tril(jnp.ones((GLA_CHUNK, GLA_CHUNK), bool))[:, :, None]

    def step(s, inp):
        qc, kc, vc, ac = inp
        cum = jnp.cumsum(ac, axis=2)
        o_inter = jnp.einsum('bhtd,bhde->bhte', qc * jnp.exp(cum), s)
        diff = cum[:, :, :, None, :] - cum[:, :, None, :, :]
        decay = jnp.where(mask, jnp.exp(jnp.where(mask, diff, 0.0)), 0.0)
        scores = jnp.einsum('bhtd,bhsd,bhtsd->bhts', qc, kc, decay)
        o_intra = jnp.einsum('bhts,bhse->bhte', scores, vc)
        total = cum[:, :, -1:, :]
        s_new = jnp.exp(total[:, :, 0, :])[..., None] * s + jnp.einsum(
            'bhsd,bhse->bhde', kc * jnp.exp(total - cum), vc)
        return s_new, o_inter + o_intra

    s_fin, o = lax.scan(step, s0, (to_chunks(q), to_chunks(k), to_chunks(v), to_chunks(log_a)))
    return jnp.moveaxis(o, 0, 2).reshape(b, h, l, dv), s_fin


def heads(t, dh):
    b, l, _ = t.shape
    return jnp.transpose(t.reshape(b, l, GLA_HEADS, dh), (0, 2, 1, 3)).astype(jnp.float32)


def mixer(h, w_in, w_decay, b_decay, gla_norm, conv_w, w_out, s0_f, s0_b, rows):
    b, l, _ = h.shape
    proj = h @ w_in
    q, k, v, g, lr_f, lr_b, cb, cc, ch = jnp.split(proj, SPLIT_IDX, axis=-1)
    qh = heads(q, GLA_DK) * (GLA_DK ** -0.5)
    kh = heads(k, GLA_DK)
    vh = heads(v, GLA_DV)
    la_f = heads(jax.nn.log_sigmoid((lr_f @ w_decay[0] + b_decay[0]).astype(jnp.float32)) / GLA_TAU, GLA_DK)
    la_b = heads(jax.nn.log_sigmoid((lr_b @ w_decay[1] + b_decay[1]).astype(jnp.float32)) / GLA_TAU, GLA_DK)
    o_f, s_f = gla_chunked(qh, kh, vh, la_f, s0_f.astype(jnp.float32))
    fl = lambda t: jnp.flip(t, axis=2)
    o_b, s_b = gla_chunked(fl(qh), fl(kh), fl(vh), fl(la_b), s0_b.astype(jnp.float32))
    o = o_f + fl(o_b)
    o = o * lax.rsqrt(jnp.mean(o * o, axis=-1, keepdims=True) + EPS)
    o = jnp.transpose(o, (0, 2, 1, 3)).reshape(b, l, GLA_WIDTH) * gla_norm.astype(jnp.float32)
    o_gla = (o * jax.nn.silu(g.astype(jnp.float32))).astype(h.dtype)
    u = cc * ch
    if rows is None:
        cu = conv3_centred(u, conv_w)
    else:
        cu = conv3_centred(u.reshape(b, rows, GRID_W, CONV_WIDTH), conv_w).reshape(b, l, CONV_WIDTH)
    o_conv = cb * cu
    return jnp.concatenate([o_gla, o_conv], axis=-1) @ w_out, s_f, s_b


def block(x, mods, s0_f, s0_b, rows, norm_ffn1, w1_ffn1, w3_ffn1, w2_ffn1, norm_mix, w_in,
          w_decay, b_decay, gla_norm, conv_w, w_out, norm_ffn2, w1_ffn2, w3_ffn2, w2_ffn2):
    m = lambda i: mods[:, i, None, :]
    h = rmsnorm(x, norm_ffn1) * (1.0 + m(1)) + m(0)
    x = x + 0.5 * m(2) * swiglu(h, w1_ffn1, w3_ffn1, w2_ffn1)
    h = rmsnorm(x, norm_mix) * (1.0 + m(4)) + m(3)
    mix, s_f, s_b = mixer(h, w_in, w_decay, b_decay, gla_norm, conv_w, w_out, s0_f, s0_b, rows)
    x = x + m(5) * mix
    h = rmsnorm(x, norm_ffn2) * (1.0 + m(7)) + m(6)
    x = x + 0.5 * m(8) * swiglu(h, w1_ffn2, w3_ffn2, w2_ffn2)
    return x, s_f, s_b


def setup_inputs(seed: int = 0) -> dict:
    key = jax.random.key(seed)
    ks = jax.random.split(key, 32)
    nrm = lambda i, shape, s: jax.random.normal(ks[i], shape, jnp.float32) * s
    gain = lambda i, shape: 1.0 + 0.05 * jax.random.normal(ks[i], shape, jnp.float32)
    return {
        "x_prompt": nrm(0, (BATCH, SEQ, D_MODEL), 1.0),
        "x_sample": nrm(1, (DEC_BATCH, DEC_SEQ, D_MODEL), 1.0),
        "state_gla": nrm(2, (DEC_BATCH, DEPTH, 2, GLA_HEADS, GLA_DK, GLA_DV), 0.5),
        "c": nrm(3, (DEC_BATCH, D_MODEL), 1.0),
        "c_ctx": nrm(4, (D_MODEL,), 1.0),
        "w_ada": nrm(5, (DEPTH, D_MODEL, N_MOD * D_MODEL), D_MODEL ** -0.5),
        "b_ada": nrm(6, (DEPTH, N_MOD * D_MODEL), 0.02),
        "norm_ffn1": gain(7, (DEPTH, D_MODEL)),
        "w1_ffn1": nrm(8, (DEPTH, D_MODEL, D_FF), D_MODEL ** -0.5),
        "w3_ffn1": nrm(9, (DEPTH, D_MODEL, D_FF), D_MODEL ** -0.5),
        "w2_ffn1": nrm(10, (DEPTH, D_FF, D_MODEL), D_FF ** -0.5),
        "norm_mix": gain(11, (DEPTH, D_MODEL)),
        "w_in": nrm(12, (DEPTH, D_MODEL, IN_COLS), D_MODEL ** -0.5),
        "w_decay": nrm(13, (DEPTH, 2, GLA_LOWRANK, QK_W), GLA_LOWRANK ** -0.5),
        "b_decay": nrm(14, (DEPTH, 2, QK_W), 0.1),
        "gla_norm": gain(15, (DEPTH, GLA_WIDTH)),
        "conv_w": nrm(16, (DEPTH, CONV_K, CONV_WIDTH), CONV_K ** -0.5),
        "w_out": nrm(17, (DEPTH, MIX_WIDTH, D_MODEL), MIX_WIDTH ** -0.5),
        "norm_ffn2": gain(18, (DEPTH, D_MODEL)),
        "w1_ffn2": nrm(19, (DEPTH, D_MODEL, D_FF), D_MODEL ** -0.5),
        "w3_ffn2": nrm(20, (DEPTH, D_MODEL, D_FF), D_MODEL ** -0.5),
        "w2_ffn2": nrm(21, (DEPTH, D_FF, D_MODEL), D_FF ** -0.5),
        "final_norm": gain(22, (D_MODEL,)),
    }


def reference(x_prompt, x_sample, state_gla, c, c_ctx, w_ada, b_ada, norm_ffn1, w1_ffn1, w3_ffn1,
              w2_ffn1, norm_mix, w_in, w_decay, b_decay, gla_norm, conv_w, w_out, norm_ffn2,
              w1_ffn2, w3_ffn2, w2_ffn2, final_norm):
    rows = x_sample.shape[1] // GRID_W
    xp, xs = x_prompt, x_sample
    new_states = []
    for l in range(DEPTH):
        lw = (norm_ffn1[l], w1_ffn1[l], w3_ffn1[l], w2_ffn1[l], norm_mix[l], w_in[l], w_decay[l],
              b_decay[l], gla_norm[l], conv_w[l], w_out[l], norm_ffn2[l], w1_ffn2[l], w3_ffn2[l], w2_ffn2[l])
        mod_ctx = ada_mod(c_ctx[None, :], w_ada[l], b_ada[l])
        zeros = jnp.zeros((xp.shape[0], GLA_HEADS, GLA_DK, GLA_DV), jnp.float32)
        xp, s_f, s_b = block(xp, mod_ctx, zeros, zeros, None, *lw)
        new_states.append(jnp.stack([s_f, s_b], axis=1))
        mod_lat = ada_mod(c, w_ada[l], b_ada[l])
        xs, _, _ = block(xs, mod_lat, state_gla[:, l, 0], state_gla[:, l, 1], rows, *lw)
    y_prompt = rmsnorm(xp, final_norm)
    y_sample = rmsnorm(xs, final_norm)
    new_state_gla = jnp.stack(new_states, axis=1)
    return (y_prompt, y_sample, new_state_gla)
```

```cpp
#include <hip/hip_runtime.h>
#include <hip/hip_cooperative_groups.h>
#include <cstdio>
#include <cstdint>
namespace cg = cooperative_groups;
namespace pg8 {
#define PG8_LAS __attribute__((address_space(3)))
typedef unsigned short bf16_t;
typedef short bf16x8 __attribute__((ext_vector_type(8)));
typedef float f32x4 __attribute__((ext_vector_type(4)));
typedef unsigned u32x4 __attribute__((ext_vector_type(4)));
constexpr int BM = 256, BK = 64, HALF = 128, HTB = HALF * BK * 2  , STAGE_BYTES = 8 * HTB, NXCD = 8, WGM = 8;

__host__ __device__ __forceinline__ int lds_byte(int r, int c) { const int st = (r >> 4) * 2 + (c >> 5), rr = r & 15, cc = c & 31, ob = rr * 64 + cc * 2; return st * 1024 + (ob ^ (((ob >> 9) & 1) << 5)); }
__host__ __device__ __forceinline__ void stage_rc(int b, int& R, int& C) { const int st = b / 1024, sb = b % 1024, swz = sb ^ (((sb >> 9) & 1) << 5); R = (st >> 1) * 16 + swz / 64; C = (st & 1) * 32 + (swz % 64) / 2; }
__host__ __device__ __forceinline__ int perm32(int rho) { const int n = rho >> 4, i = rho & 15; return 8 * (i >> 2) + 4 * n + (i & 3); }

struct Unit { int pm, pn; };
struct Gemm { const bf16_t* A; const bf16_t* Bt; int M, N, K; };

struct StaticOrder {
    int nM, nN, nwg, G, c;
    __host__ __device__ void init(int M, int N, int G_, int c_) { nM = M / BM; nN = N / BM; nwg = nM * nN; G = G_; c = c_; }
    __host__ __device__ bool next(int i, Unit& u) const {
        const long L = (long)i * G + c; if (L >= nwg) return false;
        int wgid = (int)L; { const int q = nwg / NXCD, r = nwg % NXCD, xcd = wgid % NXCD, off = wgid / NXCD; wgid = (xcd < r ? xcd * (q + 1) : r * (q + 1) + (xcd - r) * q) + off; }
        const int nig = WGM * nN, gid = wgid / nig, fm = gid * WGM, gsz = (nM - fm) < WGM ? (nM - fm) : WGM;
        u.pm = fm + ((wgid % nig) % gsz); u.pn = (wgid % nig) / gsz; return true;
    }
    __device__ __forceinline__ void a_ready(const Unit&) const {}
    __device__ __forceinline__ void done(const Unit&) const {}
};

__device__ __forceinline__ unsigned cvt_pk_bf16(float lo, float hi) { unsigned r; asm volatile("v_cvt_pk_bf16_f32 %0, %1, %2" : "=v"(r) : "v"(lo), "v"(hi)); return r; }
typedef float f32x2 __attribute__((ext_vector_type(2)));
__device__ __forceinline__ f32x2 gelu_pk(f32x2 v) {
    const f32x2 av = __builtin_elementwise_abs(v), d = av * 0.2316418882f + 1.0f;
    f32x2 t; t.x = __builtin_amdgcn_rcpf(d.x); t.y = __builtin_amdgcn_rcpf(d.y);
    f32x2 q = t * 0.5307027145f + (-0.7265760135f); q = q * t + 0.7107068705f; q = q * t + (-0.142248368f); q = q * t + 0.127414796f; q = q * t;
    const f32x2 s = (v * v) * (-0.72134752044f);
    f32x2 e; e.x = __builtin_amdgcn_exp2f(s.x); e.y = __builtin_amdgcn_exp2f(s.y);
    const f32x2 m = v * (q * e), r = v - m;
    f32x2 o; o.x = v.x < 0.f ? m.x : r.x; o.y = v.y < 0.f ? m.y : r.y; return o;
}

template <int ACT  > struct EpiBf16 {
    static constexpr bool PERM = true, AFTER_DRAIN = false; static_assert(ACT == 0 || ACT == 1, "EpiBf16: ACT is 0 (none) or 1 (gelu_pk)");
    bf16_t* O; int ldc; const float* bias; int split_cols; size_t split_stride; float scale0;
    __device__ __forceinline__ void operator()(const f32x4 (&acc)[2][2][4][2], const Unit& u, int wr, int wc, int fr, int fq) const {
        const int row0 = u.pm * BM + wr * 64 + fr; int colt = u.pn * BM; bf16_t* base = O;
        float sc = 1.f; if (split_cols) { const int t = colt / split_cols; base += (size_t)t * split_stride; colt -= t * split_cols; if (t == 0) sc = scale0; }
        const int col0 = colt + wc * 32 + 8 * fq, bcol0 = u.pn * BM + wc * 32 + 8 * fq;
        f32x4 bv[2][2];
#pragma unroll
        for (int bj = 0; bj < 2; ++bj)
#pragma unroll
            for (int n = 0; n < 2; ++n) bv[bj][n] = bias ? *(const f32x4*)(bias + bcol0 + bj * HALF + 4 * n) : (f32x4){0.f, 0.f, 0.f, 0.f};
#pragma unroll
        for (int ai = 0; ai < 2; ++ai)
#pragma unroll
            for (int m = 0; m < 4; ++m) { bf16_t* rowp = base + (size_t)(row0 + ai * HALF + m * 16) * ldc + col0;
#pragma unroll
                for (int bj = 0; bj < 2; ++bj) { f32x4 v0 = acc[ai][bj][m][0] + bv[bj][0], v1 = acc[ai][bj][m][1] + bv[bj][1];
                    if (ACT == 1) { f32x2 a = gelu_pk((f32x2){v0[0], v0[1]}), b = gelu_pk((f32x2){v0[2], v0[3]}), c = gelu_pk((f32x2){v1[0], v1[1]}), d = gelu_pk((f32x2){v1[2], v1[3]});
                        v0 = (f32x4){a.x, a.y, b.x, b.y}; v1 = (f32x4){c.x, c.y, d.x, d.y}; }
                    v0 = v0 * sc; v1 = v1 * sc; u32x4 w; w.x = cvt_pk_bf16(v0[0], v0[1]); w.y = cvt_pk_bf16(v0[2], v0[3]); w.z = cvt_pk_bf16(v1[0], v1[1]); w.w = cvt_pk_bf16(v1[2], v1[3]);
                    *(u32x4*)(rowp + bj * HALF) = w; } }
    }
};

template <class Epi, class Sched, bool ALIGN_EPI = false, bool SP2 = false>
__device__ __forceinline__ void gemm_phase(PG8_LAS unsigned char* lds, const Gemm g, const Sched& S, const Epi& E) {
    const int tid = threadIdx.x, wid = __builtin_amdgcn_readfirstlane(tid >> 6), lane = tid & 63, wr = wid >> 2, wc = wid & 3, fr = lane & 15, fq = lane >> 4;
    const int K = g.K, nt = K / BK;
    unsigned voffA[2], voffB[2];
#pragma unroll
    for (int i = 0; i < 2; ++i) { int R, C; stage_rc(tid * 16 + i * 8192, R, C); const int Rb = Epi::PERM ? ((R & ~31) + perm32(R & 31)) : R;
        voffA[i] = (unsigned)(R * K + C) * 2u; voffB[i] = (unsigned)(Rb * K + C) * 2u; }
    const size_t kstep = (size_t)(BK * 2);
    const size_t hstep = (size_t)HALF * K * 2;
    const size_t tstep = 2 * hstep;
    const unsigned ldsw = (unsigned)wid * 1024u;
    const int aoff = lds_byte(wr * 64 + fr, fq * 8), boff = lds_byte(wc * 32 + fr, fq * 8);
#define PG8_SA(b, h) (((b) * 2 + (h)) * HTB)
#define PG8_SB(b, h) ((4 + (b) * 2 + (h)) * HTB)
#define PG8_STAGE(bufoff, gbase, voff) do { _Pragma("unroll") for (int _i = 0; _i < 2; ++_i) \
        __builtin_amdgcn_global_load_lds((const unsigned*)((const char*)(gbase) + (voff)[_i]), (PG8_LAS unsigned*)(lds + (bufoff) + ldsw + _i * 8192), 16, 0, 0); } while (0)
#define PG8_LDA(dst, b, h) do { _Pragma("unroll") for (int m = 0; m < 4; ++m) _Pragma("unroll") for (int k = 0; k < 2; ++k) dst[m][k] = *(const PG8_LAS bf16x8*)(lds + PG8_SA(b, h) + aoff + m * 2048 + k * 1024); } while (0)
#define PG8_LDB(dst, b, h) do { _Pragma("unroll") for (int n = 0; n < 2; ++n) _Pragma("unroll") for (int k = 0; k < 2; ++k) dst[n][k] = *(const PG8_LAS bf16x8*)(lds + PG8_SB(b, h) + boff + n * 2048 + k * 1024); } while (0)
#define PG8_MMA(ai, bj, At, Bt) do { __builtin_amdgcn_s_setprio(1); _Pragma("unroll") for (int m = 0; m < 4; ++m) _Pragma("unroll") for (int n = 0; n < 2; ++n) _Pragma("unroll") for (int k = 0; k < 2; ++k) \
        acc[ai][bj][m][n] = __builtin_amdgcn_mfma_f32_16x16x32_bf16(Bt[n][k], At[m][k], acc[ai][bj][m][n], 0, 0, 0); __builtin_amdgcn_s_setprio(0); } while (0)
#define PG8_WAIT_V(n) asm volatile("s_waitcnt vmcnt(" #n ")" ::: "memory")
#define PG8_WAIT_L(n) asm volatile("s_waitcnt lgkmcnt(" #n ")" ::: "memory")
#define PG8_BAR __builtin_amdgcn_s_barrier()
#define PG8_SCHED __builtin_amdgcn_sched_barrier(0)
    Unit cur, nxt; int ui = 0;
    if (!S.next(0, cur)) return;
    f32x4 acc[2][2][4][2];
#pragma unroll
    for (int a = 0; a < 2; ++a)
#pragma unroll
        for (int b = 0; b < 2; ++b)
#pragma unroll
            for (int m = 0; m < 4; ++m)
#pragma unroll
                for (int n = 0; n < 2; ++n) acc[a][b][m][n] = (f32x4){0.f, 0.f, 0.f, 0.f};
    bf16x8 At[4][2], B0[2][2], B1[2][2];
    const char* cA = (const char*)g.A + (size_t)cur.pm * tstep; const char* cB = (const char*)g.Bt + (size_t)cur.pn * tstep;
    S.a_ready(cur);
    if constexpr (SP2) {
        PG8_STAGE(PG8_SB(0, 0), cB, voffB); PG8_STAGE(PG8_SB(0, 1), cB + hstep, voffB); PG8_STAGE(PG8_SA(0, 0), cA, voffA); PG8_STAGE(PG8_SA(0, 1), cA + hstep, voffA);
        if (wr == 1) PG8_BAR;
        PG8_WAIT_V(2); PG8_BAR;
        PG8_STAGE(PG8_SB(1, 0), cB + kstep, voffB); PG8_STAGE(PG8_SA(1, 0), cA + kstep, voffA); PG8_STAGE(PG8_SB(1, 1), cB + hstep + kstep, voffB);
        PG8_WAIT_V(6); PG8_BAR;
    } else {
        PG8_STAGE(PG8_SB(0, 0), cB, voffB); PG8_STAGE(PG8_SA(0, 0), cA, voffA); PG8_STAGE(PG8_SB(0, 1), cB + hstep, voffB); PG8_STAGE(PG8_SA(0, 1), cA + hstep, voffA);
        if (wr == 1) PG8_BAR;
        PG8_WAIT_V(4); PG8_BAR;
        PG8_STAGE(PG8_SB(1, 0), cB + kstep, voffB); PG8_STAGE(PG8_SA(1, 0), cA + kstep, voffA); PG8_STAGE(PG8_SB(1, 1), cB + hstep + kstep, voffB);
        PG8_WAIT_V(6); PG8_BAR;
    }
    for (;;) {
        const bool has_next = S.next(ui + 1, nxt);
        const char* nA = has_next ? (const char*)g.A + (size_t)nxt.pm * tstep : cA; const char* nB = has_next ? (const char*)g.Bt + (size_t)nxt.pn * tstep : cB;
        for (int t = 0; t < nt; t += 2) {
            const bool last = (t == nt - 2);
            const char* a1 = cA + (size_t)(t + 1) * kstep;
            const char* a2 = last ? nA : cA + (size_t)(t + 2) * kstep; const char* b2 = last ? nB : cB + (size_t)(t + 2) * kstep;
            const char* a3 = a2 + kstep; const char* b3 = b2 + kstep;
            if (last && has_next) S.a_ready(nxt);
            if constexpr (SP2) {
            PG8_LDB(B0, 0, 0); PG8_LDB(B1, 0, 1); PG8_SCHED; PG8_LDA(At, 0, 0); PG8_STAGE(PG8_SA(1, 1), a1 + hstep, voffA);
            PG8_WAIT_V(8); PG8_WAIT_L(0); PG8_BAR; PG8_MMA(0, 0, At, B0); PG8_MMA(0, 1, At, B1); PG8_BAR; PG8_SCHED;
            PG8_LDA(At, 0, 1); PG8_STAGE(PG8_SB(0, 0), b2, voffB); PG8_STAGE(PG8_SB(0, 1), b2 + hstep, voffB); PG8_STAGE(PG8_SA(0, 0), a2, voffA);
            PG8_WAIT_V(8); PG8_WAIT_L(0); PG8_BAR; PG8_MMA(1, 0, At, B0); PG8_MMA(1, 1, At, B1); PG8_BAR; PG8_SCHED;
            PG8_LDB(B0, 1, 0); PG8_LDB(B1, 1, 1); PG8_SCHED; PG8_LDA(At, 1, 0); PG8_STAGE(PG8_SA(0, 1), a2 + hstep, voffA);
            PG8_WAIT_V(8); PG8_WAIT_L(0); PG8_BAR; PG8_MMA(0, 0, At, B0); PG8_MMA(0, 1, At, B1); PG8_BAR; PG8_SCHED;
            PG8_LDA(At, 1, 1); PG8_STAGE(PG8_SB(1, 0), b3, voffB); PG8_STAGE(PG8_SB(1, 1), b3 + hstep, voffB); PG8_STAGE(PG8_SA(1, 0), a3, voffA);
            PG8_WAIT_V(8); PG8_WAIT_L(0); PG8_BAR; PG8_MMA(1, 0, At, B0); PG8_MMA(1, 1, At, B1); PG8_BAR; PG8_SCHED;
            } else {
            PG8_LDB(B0, 0, 0); PG8_SCHED; PG8_LDA(At, 0, 0); PG8_STAGE(PG8_SA(1, 1), a1 + hstep, voffA);
            PG8_WAIT_L(8); PG8_BAR; PG8_WAIT_L(0); PG8_MMA(0, 0, At, B0); PG8_BAR; PG8_SCHED;
            PG8_LDB(B1, 0, 1); PG8_STAGE(PG8_SB(0, 0), b2, voffB);
            PG8_BAR; PG8_WAIT_L(0); PG8_MMA(0, 1, At, B1); PG8_BAR;
            PG8_LDA(At, 0, 1); PG8_STAGE(PG8_SA(0, 0), a2, voffA);
            PG8_BAR; PG8_WAIT_L(0); PG8_MMA(1, 0, At, B0); PG8_BAR; PG8_SCHED;
            PG8_STAGE(PG8_SB(0, 1), b2 + hstep, voffB);
            PG8_WAIT_V(6); PG8_BAR; PG8_MMA(1, 1, At, B1); PG8_BAR;
            PG8_LDB(B0, 1, 0); PG8_SCHED; PG8_LDA(At, 1, 0); PG8_STAGE(PG8_SA(0, 1), a2 + hstep, voffA);
            PG8_WAIT_L(8); PG8_BAR; PG8_WAIT_L(0); PG8_MMA(0, 0, At, B0); PG8_BAR; PG8_SCHED;
            PG8_LDB(B1, 1, 1); PG8_STAGE(PG8_SB(1, 0), b3, voffB);
            PG8_BAR; PG8_WAIT_L(0); PG8_MMA(0, 1, At, B1); PG8_BAR;
            PG8_LDA(At, 1, 1); PG8_STAGE(PG8_SA(1, 0), a3, voffA);
            PG8_BAR; PG8_WAIT_L(0); PG8_MMA(1, 0, At, B0); PG8_BAR; PG8_SCHED;
            PG8_STAGE(PG8_SB(1, 1), b3 + hstep, voffB);
            PG8_WAIT_V(6); PG8_BAR; PG8_MMA(1, 1, At, B1); PG8_BAR;
            }
        }
        if constexpr (ALIGN_EPI) { if (wr == 0) PG8_BAR; }
        if constexpr (!Epi::AFTER_DRAIN) { E(acc, cur, wr, wc, fr, fq); S.done(cur); }
        if (!has_next) break;
#pragma unroll
        for (int a = 0; a < 2; ++a)
#pragma unroll
            for (int b = 0; b < 2; ++b)
#pragma unroll
                for (int m = 0; m < 4; ++m)
#pragma unroll
                    for (int n = 0; n < 2; ++n) acc[a][b][m][n] = (f32x4){0.f, 0.f, 0.f, 0.f};
        cur = nxt; cA = nA; cB = nB; ++ui;
        if constexpr (ALIGN_EPI) { if (wr == 1) PG8_BAR; }
    }
    PG8_WAIT_V(0);
    if constexpr (!ALIGN_EPI) { if (wr == 0) PG8_BAR; }
    PG8_BAR;
    if constexpr (Epi::AFTER_DRAIN) { E.fused(acc, cur, wr, wc, fr, fq, lds, wid, lane); S.done(cur); }
#undef PG8_SA
#undef PG8_SB
#undef PG8_STAGE
#undef PG8_LDA
#undef PG8_LDB
#undef PG8_MMA
#undef PG8_WAIT_V
#undef PG8_WAIT_L
#undef PG8_BAR
#undef PG8_SCHED
}
}

#define GAS __attribute__((address_space(1)))
#define LAS __attribute__((address_space(3)))
typedef unsigned short bf16;
typedef unsigned v4u __attribute__((ext_vector_type(4)));
typedef unsigned v2u __attribute__((ext_vector_type(2)));
typedef float f32x4 __attribute__((ext_vector_type(4)));
typedef short bf16x8 __attribute__((ext_vector_type(8)));

constexpr int NTOK = 16384, NP = 8192, DM = 1024, DFF = 2816, NIN = 3104, NINP = 3328;
constexpr int NMOD = 9, NMODROW = 5;
constexpr float EPS = 1e-6f;
constexpr int PC_Q = 0, PC_K = 256, PC_V = 512, PC_G = 1024, PC_LR = 1536, PC_CB = 1568, PC_CC = 2080, PC_CH = 2592;

constexpr size_t MiB = 1u << 20;
constexpr size_t WS_MODS = 0;
constexpr size_t WS_WUP1 = 1 * MiB, WS_WDN1 = 12 * MiB, WS_WIN = 18 * MiB, WS_WOUT = 25 * MiB, WS_WUP2 = 27 * MiB, WS_WDN2 = 38 * MiB;
constexpr size_t WS_H = 44 * MiB;
constexpr size_t WS_PROJ = 76 * MiB;
constexpr size_t WS_STATE = 180 * MiB;
constexpr size_t WS_TOT = 244 * MiB;
constexpr size_t WS_END = 245 * MiB;
constexpr int LDS_BYTES = 147456;

__device__ __forceinline__ float bf2f(unsigned b) { return __uint_as_float(b << 16); }
__device__ __forceinline__ float bflo(unsigned w) { return __uint_as_float(w << 16); }
__device__ __forceinline__ float bfhi(unsigned w) { return __uint_as_float(w & 0xffff0000u); }
__device__ __forceinline__ unsigned pk2(float lo, float hi) { return pg8::cvt_pk_bf16(lo, hi); }
__device__ __forceinline__ float wave_sum(float v) {
#pragma unroll
    for (int o = 1; o < 64; o <<= 1) v += __shfl_xor(v, o);
    return v;
}
__device__ __forceinline__ float silu_f(float g) { return g * __builtin_amdgcn_rcpf(1.f + __expf(-g)); }

struct EpiSwiglu {
    static constexpr bool PERM = true, AFTER_DRAIN = false;
    bf16* O; int ldc;
    __device__ __forceinline__ void operator()(const pg8::f32x4 (&acc)[2][2][4][2], const pg8::Unit& u, int wr, int wc, int fr, int fq) const {
        const int row0 = u.pm * 256 + wr * 64 + fr, col0 = u.pn * 128 + wc * 32 + 8 * fq;
#pragma unroll
        for (int ai = 0; ai < 2; ++ai)
#pragma unroll
            for (int m = 0; m < 4; ++m) {
                bf16* rowp = O + (size_t)(row0 + ai * 128 + m * 16) * ldc + col0;
                const pg8::f32x4 g0 = acc[ai][0][m][0], g1 = acc[ai][0][m][1], u0 = acc[ai][1][m][0], u1 = acc[ai][1][m][1];
                v4u w;
                w.x = pk2(silu_f(g0[0]) * u0[0], silu_f(g0[1]) * u0[1]);
                w.y = pk2(silu_f(g0[2]) * u0[2], silu_f(g0[3]) * u0[3]);
                w.z = pk2(silu_f(g1[0]) * u1[0], silu_f(g1[1]) * u1[1]);
                w.w = pk2(silu_f(g1[2]) * u1[2], silu_f(g1[3]) * u1[3]);
                *(v4u*)rowp = w;
            }
    }
};
struct EpiResid {
    static constexpr bool PERM = true, AFTER_DRAIN = false;
    const float* base0; const float* base1; float* out; const float* mods; int modrow; float scale;
    __device__ __forceinline__ void operator()(const pg8::f32x4 (&acc)[2][2][4][2], const pg8::Unit& u, int wr, int wc, int fr, int fq) const {
        const int mi = u.pm < 32 ? 0 : 1 + ((u.pm - 32) >> 3);
        const float* mrow = mods + (size_t)(mi * NMOD + modrow) * DM;
        const int row0 = u.pm * 256 + wr * 64 + fr, col0 = u.pn * 256 + wc * 32 + 8 * fq;
        f32x4 mv[2][2];
#pragma unroll
        for (int bj = 0; bj < 2; ++bj)
#pragma unroll
            for (int n = 0; n < 2; ++n) mv[bj][n] = *(const f32x4*)(mrow + col0 + bj * 128 + 4 * n) * scale;
#pragma unroll
        for (int ai = 0; ai < 2; ++ai)
#pragma unroll
            for (int m = 0; m < 4; ++m) {
                const int row = row0 + ai * 128 + m * 16;
                const float* bp = (row < NP ? base0 + (size_t)row * DM : base1 + (size_t)(row - NP) * DM) + col0;
                float* op = out + (size_t)row * DM + col0;
#pragma unroll
                for (int bj = 0; bj < 2; ++bj)
#pragma unroll
                    for (int n = 0; n < 2; ++n) {
                        const f32x4 b = *(const f32x4*)(bp + bj * 128 + 4 * n);
                        *(f32x4*)(op + bj * 128 + 4 * n) = b + mv[bj][n] * acc[ai][bj][m][n];
                    }
            }
    }
};

__device__ __forceinline__ void phase_mods(LAS unsigned char* L, const float* c, const float* c_ctx, const float* w_ada, const float* b_ada, float* MODS, int tid) {
    LAS float* SC = (LAS float*)L;
    LAS float* RED = (LAS float*)(L + 20480);
    for (int i = tid; i < NMODROW * DM; i += 512) { const int j = i >> 10, k = i & 1023; const float v = j == 0 ? c_ctx[k] : c[(j - 1) * DM + k]; SC[i] = v / (1.f + expf(-v)); }
    __syncthreads();
    for (int cb = blockIdx.x; cb < 256; cb += gridDim.x) {
        const int n0 = cb * 36;
        if (tid < 504) {
            const int ci = tid % 36, kg = tid / 36;
            float a0 = 0.f, a1 = 0.f, a2 = 0.f, a3 = 0.f, a4 = 0.f;
#pragma unroll 8
            for (int k = kg; k < DM; k += 14) {
                const float w = w_ada[(size_t)k * (NMOD * DM) + n0 + ci];
                a0 += SC[k] * w; a1 += SC[DM + k] * w; a2 += SC[2 * DM + k] * w; a3 += SC[3 * DM + k] * w; a4 += SC[4 * DM + k] * w;
            }
            LAS float* r = RED + (kg * 36 + ci) * 5; r[0] = a0; r[1] = a1; r[2] = a2; r[3] = a3; r[4] = a4;
        }
        __syncthreads();
        if (tid < 180) {
            const int ci = tid % 36, j = tid / 36; float s = b_ada[n0 + ci];
#pragma unroll
            for (int kg = 0; kg < 14; ++kg) s += RED[(kg * 36 + ci) * 5 + j];
            MODS[(size_t)j * (NMOD * DM) + n0 + ci] = s;
        }
        __syncthreads();
    }
}
__device__ __forceinline__ void transpose_item(const float* W, int K, int N, bf16* WT, int k0, int n0, int drow0, LAS float* scr, int lane) {
#pragma unroll 8
    for (int i = 0; i < 32; ++i) { const int kk = 2 * i + (lane >> 5); scr[kk * 33 + (lane & 31)] = W[(size_t)(k0 + kk) * N + n0 + (lane & 31)]; }
    asm volatile("s_waitcnt lgkmcnt(0)" ::: "memory");
    const int c = lane & 7;
#pragma unroll
    for (int j = 0; j < 4; ++j) { const int n = (lane >> 3) + 8 * j; const LAS float* s = scr + (8 * c) * 33 + n;
        v4u o; o.x = pk2(s[0 * 33], s[1 * 33]); o.y = pk2(s[2 * 33], s[3 * 33]); o.z = pk2(s[4 * 33], s[5 * 33]); o.w = pk2(s[6 * 33], s[7 * 33]);
        *(v4u*)(WT + (size_t)(drow0 + n) * K + k0 + 8 * c) = o; }
    asm volatile("s_waitcnt lgkmcnt(0)" ::: "memory");
}
struct WPtrs { const float *w1a, *w3a, *w2a, *win, *wout, *w1b, *w3b, *w2b; };
__device__ __forceinline__ void phase_weights(LAS unsigned char* L, const WPtrs& W, unsigned char* ws, int gw, int NGW, int wave, int lane, int gtid, int nthr) {
    LAS float* scr = (LAS float*)(L + 32768 + wave * 8704);
    constexpr int I_UP = 16 * 88, I_DN = 44 * 32, I_IN = 16 * 97, I_OUT = 16 * 32;
    constexpr int NITEMS = 4 * I_UP + 2 * I_DN + I_IN + I_OUT;
    for (int it = gw; it < NITEMS; it += NGW) {
        int r = it;
        if (r < 4 * I_UP) {
            const int which = r / I_UP; r -= which * I_UP; const int kb = r / 88, nb = r % 88, n0 = nb * 32;
            const float* src = which == 0 ? W.w1a : which == 1 ? W.w3a : which == 2 ? W.w1b : W.w3b;
            bf16* dst = (bf16*)(ws + (which < 2 ? WS_WUP1 : WS_WUP2));
            transpose_item(src, DM, DFF, dst, kb * 64, n0, (n0 >> 7) * 256 + (which & 1) * 128 + (n0 & 127), scr, lane); continue; }
        r -= 4 * I_UP;
        if (r < 2 * I_DN) { const int which = r / I_DN; r -= which * I_DN; const int kb = r / 32, nb = r % 32;
            transpose_item(which == 0 ? W.w2a : W.w2b, DFF, DM, (bf16*)(ws + (which == 0 ? WS_WDN1 : WS_WDN2)), kb * 64, nb * 32, nb * 32, scr, lane); continue; }
        r -= 2 * I_DN;
        if (r < I_IN) { const int kb = r / 97, nb = r % 97; transpose_item(W.win, DM, NIN, (bf16*)(ws + WS_WIN), kb * 64, nb * 32, nb * 32, scr, lane); continue; }
        r -= I_IN;
        { const int kb = r / 32, nb = r % 32; transpose_item(W.wout, DM, DM, (bf16*)(ws + WS_WOUT), kb * 64, nb * 32, nb * 32, scr, lane); }
    }
    v4u* z = (v4u*)(ws + WS_WIN + (size_t)NIN * DM * 2);
    for (int i = gtid; i < (NINP - NIN) * DM / 8; i += nthr) z[i] = (v4u){0u, 0u, 0u, 0u};
}

__device__ __forceinline__ void phase_normmod(const float* x0, const float* x1, const float* gain, const float* MODS, int i_shift, int i_scale, bf16* H, int gw, int NGW, int lane) {
    for (int m = gw; m < NTOK; m += NGW) {
        const float* xrow = m < NP ? x0 + (size_t)m * DM : x1 + (size_t)(m - NP) * DM;
        const int mi = m < NP ? 0 : 1 + ((m - NP) >> 11);
        const f32x4* xr = (const f32x4*)xrow + lane;
        const f32x4* gp = (const f32x4*)gain + lane;
        const f32x4* sh = (const f32x4*)(MODS + (size_t)(mi * NMOD + i_shift) * DM) + lane;
        const f32x4* sc = (const f32x4*)(MODS + (size_t)(mi * NMOD + i_scale) * DM) + lane;
        f32x4 v[4]; float s = 0.f;
#pragma unroll
        for (int j = 0; j < 4; ++j) { v[j] = xr[64 * j]; s += (v[j].x * v[j].x + v[j].y * v[j].y) + (v[j].z * v[j].z + v[j].w * v[j].w); }
        const float rstd = rsqrtf(wave_sum(s) * (1.f / DM) + EPS);
        unsigned long long* o8 = (unsigned long long*)(H + (size_t)m * DM) + lane;
#pragma unroll
        for (int j = 0; j < 4; ++j) {
            const f32x4 g = gp[64 * j], a = sc[64 * j], b = sh[64 * j];
            const f32x4 y = (v[j] * rstd * g) * (a + 1.f) + b;
            o8[64 * j] = (unsigned long long)pk2(y.x, y.y) | ((unsigned long long)pk2(y.z, y.w) << 32);
        }
    }
}
__device__ __forceinline__ void phase_final_norm(float* X, const float* gain, int gw, int NGW, int lane) {
    for (int m = gw; m < NTOK; m += NGW) {
        f32x4* xr = (f32x4*)(X + (size_t)m * DM) + lane;
        const f32x4* gp = (const f32x4*)gain + lane;
        f32x4 v[4]; float s = 0.f;
#pragma unroll
        for (int j = 0; j < 4; ++j) { v[j] = xr[64 * j]; s += (v[j].x * v[j].x + v[j].y * v[j].y) + (v[j].z * v[j].z + v[j].w * v[j].w); }
        const float rstd = rsqrtf(wave_sum(s) * (1.f / DM) + EPS);
#pragma unroll
        for (int j = 0; j < 4; ++j) xr[64 * j] = v[j] * rstd * gp[64 * j];
    }
}

constexpr int G_LR = 0, G_WD = 8192, G_BD = 16384, G_PT = 16896, G_CUM = 18944;
constexpr int G_QK = 51712;
constexpr int G_VT = 88576;
constexpr int G_SC = 107008;
constexpr int G_SSQ = 116224;
constexpr int G_ST = 0;
constexpr int RS = 72;

__device__ __forceinline__ void gla_cum(LAS unsigned char* L, const bf16* PROJ, const float* w_decay, const float* b_decay, int row0, int h, int tid) {
    LAS float* LR = (LAS float*)(L + G_LR); LAS float* WD = (LAS float*)(L + G_WD); LAS float* BD = (LAS float*)(L + G_BD);
    LAS float* PT = (LAS float*)(L + G_PT); LAS float* CUM = (LAS float*)(L + G_CUM);
    { const int t = tid >> 3, part = tid & 7;
      const v2u raw = *(const v2u*)(PROJ + (size_t)(row0 + t) * NINP + PC_LR + 4 * part);
      LAS float* dst = LR + ((part >> 2) * 64 + t) * 16 + (part & 3) * 4;
      dst[0] = bflo(raw.x); dst[1] = bfhi(raw.x); dst[2] = bflo(raw.y); dst[3] = bfhi(raw.y); }
    { const int idx = tid * 4, dir = idx >> 10, j = (idx >> 6) & 15, d = idx & 63;
      *(LAS f32x4*)(WD + idx) = *(const f32x4*)(w_decay + dir * 4096 + j * 256 + h * 64 + d); }
    if (tid < 128) BD[tid] = b_decay[(tid >> 6) * 256 + h * 64 + (tid & 63)];
    __syncthreads();
    const int d = tid & 63, dir = (tid >> 6) & 1, part = tid >> 7;
    {
        float wreg[16];
#pragma unroll
        for (int j = 0; j < 16; ++j) wreg[j] = WD[dir * 1024 + j * 64 + d];
        const float bias = BD[dir * 64 + d];
        float run = 0.f;
#pragma unroll
        for (int i = 0; i < 16; ++i) {
            const int t = dir == 0 ? part * 16 + i : part * 16 + 15 - i;
            const LAS float* lr = LR + (dir * 64 + t) * 16;
            float x = bias;
#pragma unroll
            for (int j = 0; j < 16; ++j) x += lr[j] * wreg[j];
            const float la = (fminf(x, 0.f) - log1pf(expf(-fabsf(x)))) * (1.f / 16.f);
            run += la; CUM[(dir * 64 + t) * 64 + d] = run;
        }
        PT[(dir * 4 + part) * 64 + d] = run;
    }
    __syncthreads();
    {
        float off = 0.f;
#pragma unroll
        for (int p = 0; p < 4; ++p) { const float v = PT[(dir * 4 + p) * 64 + d]; if (dir == 0 ? p < part : p > part) off += v; }
#pragma unroll
        for (int i = 0; i < 16; ++i) CUM[(dir * 64 + part * 16 + i) * 64 + d] += off;
    }
    __syncthreads();
}
__device__ __forceinline__ void gla_load_vt(LAS unsigned char* L, const bf16* PROJ, int row0, int h, int tid) {
    LAS bf16* VT = (LAS bf16*)(L + G_VT);
    const int s = tid >> 3, e0 = (tid & 7) * 16;
    const v4u* src = (const v4u*)(PROJ + (size_t)(row0 + s) * NINP + PC_V + h * 128 + e0);
    const v4u a = src[0], b = src[1];
    const unsigned w[8] = {a.x, a.y, a.z, a.w, b.x, b.y, b.z, b.w};
#pragma unroll
    for (int i = 0; i < 8; ++i) { VT[(e0 + 2 * i) * RS + s] = (bf16)(w[i] & 0xffffu); VT[(e0 + 2 * i + 1) * RS + s] = (bf16)(w[i] >> 16); }
}
#define MFMA16(a, b, c) __builtin_amdgcn_mfma_f32_16x16x32_bf16((a), (b), (c), 0, 0, 0)
#define LDFRAG(base, row, kk) (*(const LAS bf16x8*)((base) + (row) * RS + (kk) * 32 + fq * 8))

__device__ __forceinline__ void phase_gla_local(LAS unsigned char* L, const bf16* PROJ, const float* w_decay, const float* b_decay, float* STATE, float* TOT, int tid) {
    const int wave = tid >> 6, lane = tid & 63, fr = lane & 15, fq = lane >> 4;
    LAS float* CUM = (LAS float*)(L + G_CUM); LAS bf16* KT = (LAS bf16*)(L + G_QK); LAS bf16* VT = (LAS bf16*)(L + G_VT);
    for (int unit = blockIdx.x; unit < 1024; unit += gridDim.x) {
        const int gc = unit >> 2, h = unit & 3, row0 = gc * 64;
        gla_cum(L, PROJ, w_decay, b_decay, row0, h, tid);
        { const int s = tid >> 3, d0 = (tid & 7) * 8;
          const v4u kr = *(const v4u*)(PROJ + (size_t)(row0 + s) * NINP + PC_K + h * 64 + d0);
          const unsigned w[4] = {kr.x, kr.y, kr.z, kr.w};
#pragma unroll
          for (int i = 0; i < 8; ++i) {
              const int d = d0 + i; const float k = (i & 1) ? bfhi(w[i >> 1]) : bflo(w[i >> 1]);
              const float tf = CUM[(63) * 64 + d], tb = CUM[(64 + 0) * 64 + d];
              const float cf = CUM[s * 64 + d], cb = CUM[(64 + s) * 64 + d];
              const unsigned pf = pk2(k * expf(tf - cf), 0.f), pb = pk2(k * expf(tb - cb), 0.f);
              KT[(d) * RS + s] = (bf16)(pf & 0xffffu); KT[(64 + d) * RS + s] = (bf16)(pb & 0xffffu);
          } }
        gla_load_vt(L, PROJ, row0, h, tid);
        if (tid < 128) { const int dir = tid >> 6, d = tid & 63; TOT[(size_t)((gc * 4 + h) * 2 + dir) * 64 + d] = dir == 0 ? CUM[63 * 64 + d] : CUM[64 * 64 + d]; }
        __syncthreads();
        { const int dir = wave >> 2, dt = wave & 3;
          const bf16x8 q0 = LDFRAG(KT, dir * 64 + dt * 16 + fr, 0), q1 = LDFRAG(KT, dir * 64 + dt * 16 + fr, 1);
          float* dst = STATE + (size_t)((gc * 4 + h) * 2 + dir) * 8192 + (dt * 16 + fr) * 128 + 4 * fq;
#pragma unroll
          for (int i = 0; i < 8; ++i) {
              const bf16x8 p0 = LDFRAG(VT, i * 16 + fr, 0), p1 = LDFRAG(VT, i * 16 + fr, 1);
              f32x4 acc = {0.f, 0.f, 0.f, 0.f};
              acc = MFMA16(p0, q0, acc); acc = MFMA16(p1, q1, acc);
              *(f32x4*)(dst + i * 16) = acc;
          } }
        __syncthreads();
    }
}

__device__ __forceinline__ void scan_chain(int item, bool sample, float* STATE, const float* TOT, const float* state_in, float* new_state) {
    const int e4 = item & 31, d = (item >> 5) & 63, dir = (item >> 11) & 1, h = (item >> 12) & 3, seq = item >> 14;
    const int N = sample ? 32 : 4, gc0 = sample ? 128 + 32 * seq : 4 * seq;
    f32x4 S = {0.f, 0.f, 0.f, 0.f};
    const size_t sidx = (size_t)((seq * 2 + dir) * 4 + h) * 8192 + d * 128 + e4 * 4;
    if (sample) S = *(const f32x4*)(state_in + sidx);
    for (int st = 0; st < N; st += 4) {
        f32x4 loc[4]; float a[4]; float* p[4];
#pragma unroll
        for (int i = 0; i < 4; ++i) {
            const int c = dir == 0 ? st + i : N - 1 - (st + i); const size_t g = (size_t)((gc0 + c) * 4 + h) * 2 + dir;
            p[i] = STATE + g * 8192 + d * 128 + e4 * 4; loc[i] = *(const f32x4*)p[i]; a[i] = TOT[g * 64 + d];
        }
#pragma unroll
        for (int i = 0; i < 4; ++i) { *(f32x4*)p[i] = S; S = S * expf(a[i]) + loc[i]; }
    }
    if (!sample) *(f32x4*)(new_state + sidx) = S;
}
__device__ __forceinline__ void phase_scan(float* STATE, const float* TOT, const float* state_in, float* new_state, int gtid, int nthr) {
    for (int v = gtid; v < 131072; v += nthr) {
        if (v < 65536) { scan_chain(v, true, STATE, TOT, state_in, new_state); scan_chain(v, false, STATE, TOT, state_in, new_state); }
        else { for (int i = 0; i < 7; ++i) scan_chain(65536 + i * 65536 + (v - 65536), false, STATE, TOT, state_in, new_state); }
    }
}

__device__ __forceinline__ void phase_gla_out(LAS unsigned char* L, const bf16* PROJ, const float* w_decay, const float* b_decay, const float* STATE,
                                              const float* gla_norm, const float* conv_w, bf16* MIX, int tid) {
    const int wave = tid >> 6, lane = tid & 63, fr = lane & 15, fq = lane >> 4;
    LAS float* CUM = (LAS float*)(L + G_CUM);
    LAS bf16* QF = (LAS bf16*)(L + G_QK); LAS bf16* KF = QF + 64 * RS; LAS bf16* QB = KF + 64 * RS; LAS bf16* KB = QB + 64 * RS;
    LAS bf16* VT = (LAS bf16*)(L + G_VT); LAS bf16* SC = (LAS bf16*)(L + G_SC); LAS float* SSQ = (LAS float*)(L + G_SSQ);
    LAS bf16* STF = (LAS bf16*)(L + G_ST); LAS bf16* STB = STF + 128 * RS;
    for (int unit = blockIdx.x; unit < 1024; unit += gridDim.x) {
        const int gc = unit >> 2, h = unit & 3, row0 = gc * 64;
        { const int t = tid >> 3, c0 = 128 * h + (tid & 7) * 16;
          const bool sample = gc >= 128; const int tl = sample ? t : (gc & 3) * 64 + t, Lseg = sample ? 64 : 256;
          const bool hasp = tl > 0, hasn = tl < Lseg - 1;
          const bf16* prow = PROJ + (size_t)(row0 + t) * NINP;
#pragma unroll
          for (int half = 0; half < 2; ++half) {
              const int c = c0 + half * 8;
              const v4u cbv = *(const v4u*)(prow + PC_CB + c);
              const v4u ccm = *(const v4u*)(prow + PC_CC + c), chm = *(const v4u*)(prow + PC_CH + c);
              v4u ccp = {0u, 0u, 0u, 0u}, chp = ccp, ccn = ccp, chn = ccp;
              if (hasp) { ccp = *(const v4u*)(prow - NINP + PC_CC + c); chp = *(const v4u*)(prow - NINP + PC_CH + c); }
              if (hasn) { ccn = *(const v4u*)(prow + NINP + PC_CC + c); chn = *(const v4u*)(prow + NINP + PC_CH + c); }
              const unsigned cbw[4] = {cbv.x, cbv.y, cbv.z, cbv.w}, ccmw[4] = {ccm.x, ccm.y, ccm.z, ccm.w}, chmw[4] = {chm.x, chm.y, chm.z, chm.w};
              const unsigned ccpw[4] = {ccp.x, ccp.y, ccp.z, ccp.w}, chpw[4] = {chp.x, chp.y, chp.z, chp.w}, ccnw[4] = {ccn.x, ccn.y, ccn.z, ccn.w}, chnw[4] = {chn.x, chn.y, chn.z, chn.w};
              unsigned ow[4];
#pragma unroll
              for (int i = 0; i < 4; ++i) {
                  const float w0a = conv_w[c + 2 * i], w1a = conv_w[512 + c + 2 * i], w2a = conv_w[1024 + c + 2 * i];
                  const float w0b = conv_w[c + 2 * i + 1], w1b = conv_w[512 + c + 2 * i + 1], w2b = conv_w[1024 + c + 2 * i + 1];
                  const float lo = bflo(cbw[i]) * (w0a * bflo(ccpw[i]) * bflo(chpw[i]) + w1a * bflo(ccmw[i]) * bflo(chmw[i]) + w2a * bflo(ccnw[i]) * bflo(chnw[i]));
                  const float hi = bfhi(cbw[i]) * (w0b * bfhi(ccpw[i]) * bfhi(chpw[i]) + w1b * bfhi(ccmw[i]) * bfhi(chmw[i]) + w2b * bfhi(ccnw[i]) * bfhi(chnw[i]));
                  ow[i] = pk2(lo, hi);
              }
              *(v4u*)(MIX + (size_t)(row0 + t) * DM + 512 + c) = (v4u){ow[0], ow[1], ow[2], ow[3]};
          } }
        gla_cum(L, PROJ, w_decay, b_decay, row0, h, tid);
        { const int s = tid >> 3, d0 = (tid & 7) * 8;
          const v4u qr = *(const v4u*)(PROJ + (size_t)(row0 + s) * NINP + PC_Q + h * 64 + d0);
          const v4u kr = *(const v4u*)(PROJ + (size_t)(row0 + s) * NINP + PC_K + h * 64 + d0);
          const unsigned qw[4] = {qr.x, qr.y, qr.z, qr.w}, kw[4] = {kr.x, kr.y, kr.z, kr.w};
          unsigned oqf[4], okf[4], oqb[4], okb[4];
#pragma unroll
          for (int i = 0; i < 4; ++i) {
              const int d = d0 + 2 * i;
              const float cf0 = CUM[s * 64 + d], cf1 = CUM[s * 64 + d + 1], cb0 = CUM[(64 + s) * 64 + d], cb1 = CUM[(64 + s) * 64 + d + 1];
              const float q0 = bflo(qw[i]) * 0.125f, q1 = bfhi(qw[i]) * 0.125f, k0 = bflo(kw[i]), k1 = bfhi(kw[i]);
              oqf[i] = pk2(q0 * expf(cf0), q1 * expf(cf1)); okf[i] = pk2(k0 * expf(-cf0), k1 * expf(-cf1));
              oqb[i] = pk2(q0 * expf(cb0), q1 * expf(cb1)); okb[i] = pk2(k0 * expf(-cb0), k1 * expf(-cb1));
          }
          *(LAS v4u*)(QF + s * RS + d0) = (v4u){oqf[0], oqf[1], oqf[2], oqf[3]}; *(LAS v4u*)(KF + s * RS + d0) = (v4u){okf[0], okf[1], okf[2], okf[3]};
          *(LAS v4u*)(QB + s * RS + d0) = (v4u){oqb[0], oqb[1], oqb[2], oqb[3]}; *(LAS v4u*)(KB + s * RS + d0) = (v4u){okb[0], okb[1], okb[2], okb[3]}; }
        gla_load_vt(L, PROJ, row0, h, tid);
        __syncthreads();
#pragma unroll
        for (int dir = 0; dir < 2; ++dir) {
            const float* sp = STATE + (size_t)((gc * 4 + h) * 2 + dir) * 8192;
            LAS bf16* ST = dir == 0 ? STF : STB;
#pragma unroll
            for (int i = 0; i < 2; ++i) {
                const int idx = tid + 512 * i, d2 = idx >> 5, e4 = idx & 31;
                const f32x4 s0 = *(const f32x4*)(sp + (2 * d2) * 128 + e4 * 4), s1 = *(const f32x4*)(sp + (2 * d2 + 1) * 128 + e4 * 4);
#pragma unroll
                for (int r = 0; r < 4; ++r) *(LAS unsigned*)(ST + (e4 * 4 + r) * RS + 2 * d2) = pk2(s0[r], s1[r]);
            }
        }
        { const int tt = wave & 3;
          const bf16x8 qf0 = LDFRAG(QF, tt * 16 + fr, 0), qf1 = LDFRAG(QF, tt * 16 + fr, 1), qb0 = LDFRAG(QB, tt * 16 + fr, 0), qb1 = LDFRAG(QB, tt * 16 + fr, 1);
#pragma unroll
          for (int j = 0; j < 2; ++j) {
              const int st = (wave >> 2) * 2 + j;
              const bf16x8 kf0 = LDFRAG(KF, st * 16 + fr, 0), kf1 = LDFRAG(KF, st * 16 + fr, 1), kb0 = LDFRAG(KB, st * 16 + fr, 0), kb1 = LDFRAG(KB, st * 16 + fr, 1);
              f32x4 af = {0.f, 0.f, 0.f, 0.f}, ab = {0.f, 0.f, 0.f, 0.f};
              af = MFMA16(kf0, qf0, af); af = MFMA16(kf1, qf1, af);
              ab = MFMA16(kb0, qb0, ab); ab = MFMA16(kb1, qb1, ab);
              const int t = tt * 16 + fr, s0 = st * 16 + 4 * fq;
              float v[4];
#pragma unroll
              for (int r = 0; r < 4; ++r) { const int s = s0 + r; v[r] = (s <= t ? af[r] : 0.f) + (s >= t ? ab[r] : 0.f); }
              *(LAS v2u*)(SC + t * RS + s0) = (v2u){pk2(v[0], v[1]), pk2(v[2], v[3])};
          } }
        __syncthreads();
        const int tt = wave & 3, eh = wave >> 2, t = tt * 16 + fr;
        f32x4 o[4]; float ssq = 0.f;
        { const bf16x8 a0 = LDFRAG(SC, t, 0), a1 = LDFRAG(SC, t, 1), b0 = LDFRAG(QF, t, 0), b1 = LDFRAG(QF, t, 1), c0 = LDFRAG(QB, t, 0), c1 = LDFRAG(QB, t, 1);
#pragma unroll
          for (int i4 = 0; i4 < 4; ++i4) {
              const int er = (eh * 4 + i4) * 16 + fr;
              f32x4 acc = {0.f, 0.f, 0.f, 0.f};
              acc = MFMA16(LDFRAG(VT, er, 0), a0, acc); acc = MFMA16(LDFRAG(VT, er, 1), a1, acc);
              acc = MFMA16(LDFRAG(STF, er, 0), b0, acc); acc = MFMA16(LDFRAG(STF, er, 1), b1, acc);
              acc = MFMA16(LDFRAG(STB, er, 0), c0, acc); acc = MFMA16(LDFRAG(STB, er, 1), c1, acc);
              o[i4] = acc; ssq += (acc[0] * acc[0] + acc[1] * acc[1]) + (acc[2] * acc[2] + acc[3] * acc[3]);
          } }
        ssq += __shfl_xor(ssq, 16); ssq += __shfl_xor(ssq, 32);
        if (fq == 0) SSQ[eh * 64 + t] = ssq;
        __syncthreads();
        { const float rstd = rsqrtf((SSQ[t] + SSQ[64 + t]) * (1.f / 128.f) + EPS);
          const bf16* grow = PROJ + (size_t)(row0 + t) * NINP + PC_G + h * 128;
          bf16* orow = MIX + (size_t)(row0 + t) * DM + h * 128;
#pragma unroll
          for (int i4 = 0; i4 < 4; ++i4) {
              const int e = (eh * 4 + i4) * 16 + 4 * fq;
              const v2u gr = *(const v2u*)(grow + e); const f32x4 gn = *(const f32x4*)(gla_norm + h * 128 + e);
              const float y0 = o[i4][0] * rstd * gn[0] * silu_f(bflo(gr.x)), y1 = o[i4][1] * rstd * gn[1] * silu_f(bfhi(gr.x));
              const float y2 = o[i4][2] * rstd * gn[2] * silu_f(bflo(gr.y)), y3 = o[i4][3] * rstd * gn[3] * silu_f(bfhi(gr.y));
              *(v2u*)(orow + e) = (v2u){pk2(y0, y1), pk2(y2, y3)};
          } }
        __syncthreads();
    }
}

struct Args {
    const float *x_prompt, *x_sample, *state_gla, *c, *c_ctx, *w_ada, *b_ada, *norm_ffn1, *w1_ffn1, *w3_ffn1, *w2_ffn1, *norm_mix, *w_in, *w_decay, *b_decay,
                *gla_norm, *conv_w, *w_out, *norm_ffn2, *w1_ffn2, *w3_ffn2, *w2_ffn2, *final_norm;
    float* out; unsigned char* ws;
};

__global__ void __launch_bounds__(512, 2) mega_fwd(Args A) {
    extern __shared__ __attribute__((aligned(16))) unsigned char lds_raw[];
    cg::grid_group grid = cg::this_grid();
    LAS unsigned char* L = (LAS unsigned char*)lds_raw;
    const int tid = threadIdx.x, lane = tid & 63, wave = __builtin_amdgcn_readfirstlane(tid >> 6);
    const int G = gridDim.x, gw = blockIdx.x * 8 + wave, NGW = G * 8, gtid = blockIdx.x * 512 + tid, nthr = G * 512;
    unsigned char* ws = A.ws;
    float* MODS = (float*)(ws + WS_MODS);
    bf16* H = (bf16*)(ws + WS_H); bf16* MIX = H;
    bf16* PROJ = (bf16*)(ws + WS_PROJ); bf16* ACT = PROJ;
    float* STATE = (float*)(ws + WS_STATE); float* TOT = (float*)(ws + WS_TOT);
    float* RES = A.out;
    float* NEWSTATE = A.out + (size_t)NTOK * DM;

    phase_mods(L, A.c, A.c_ctx, A.w_ada, A.b_ada, MODS, tid);
    { WPtrs W{A.w1_ffn1, A.w3_ffn1, A.w2_ffn1, A.w_in, A.w_out, A.w1_ffn2, A.w3_ffn2, A.w2_ffn2};
      phase_weights(L, W, ws, gw, NGW, wave, lane, gtid, nthr); }
    grid.sync();
    phase_normmod(A.x_prompt, A.x_sample, A.norm_ffn1, MODS, 0, 1, H, gw, NGW, lane);
    grid.sync();
    { pg8::Gemm g{H, (const bf16*)(ws + WS_WUP1), NTOK, 2 * DFF, DM}; pg8::StaticOrder S; S.init(NTOK, 2 * DFF, G, (int)blockIdx.x);
      EpiSwiglu E{ACT, DFF}; pg8::gemm_phase<EpiSwiglu, pg8::StaticOrder, true, true>(L, g, S, E); }
    grid.sync();
    { pg8::Gemm g{ACT, (const bf16*)(ws + WS_WDN1), NTOK, DM, DFF}; pg8::StaticOrder S; S.init(NTOK, DM, G, (int)blockIdx.x);
      EpiResid E{A.x_prompt, A.x_sample, RES, MODS, 2, 0.5f}; pg8::gemm_phase<EpiResid, pg8::StaticOrder, true, true>(L, g, S, E); }
    grid.sync();
    phase_normmod(RES, RES + (size_t)NP * DM, A.norm_mix, MODS, 3, 4, H, gw, NGW, lane);
    grid.sync();
    { pg8::Gemm g{H, (const bf16*)(ws + WS_WIN), NTOK, NINP, DM}; pg8::StaticOrder S; S.init(NTOK, NINP, G, (int)blockIdx.x);
      pg8::EpiBf16<0> E{PROJ, NINP, nullptr, 0, 0, 1.f}; pg8::gemm_phase<pg8::EpiBf16<0>, pg8::StaticOrder, true, true>(L, g, S, E); }
    grid.sync();
    phase_gla_local(L, PROJ, A.w_decay, A.b_decay, STATE, TOT, tid);
    grid.sync();
    phase_scan(STATE, TOT, A.state_gla, NEWSTATE, gtid, nthr);
    grid.sync();
    phase_gla_out(L, PROJ, A.w_decay, A.b_decay, STATE, A.gla_norm, A.conv_w, MIX, tid);
    grid.sync();
    { pg8::Gemm g{MIX, (const bf16*)(ws + WS_WOUT), NTOK, DM, DM}; pg8::StaticOrder S; S.init(NTOK, DM, G, (int)blockIdx.x);
      EpiResid E{RES, RES + (size_t)NP * DM, RES, MODS, 5, 1.0f}; pg8::gemm_phase<EpiResid, pg8::StaticOrder, true, true>(L, g, S, E); }
    grid.sync();
    phase_normmod(RES, RES + (size_t)NP * DM, A.norm_ffn2, MODS, 6, 7, H, gw, NGW, lane);
    grid.sync();
    { pg8::Gemm g{H, (const bf16*)(ws + WS_WUP2), NTOK, 2 * DFF, DM}; pg8::StaticOrder S; S.init(NTOK, 2 * DFF, G, (int)blockIdx.x);
      EpiSwiglu E{ACT, DFF}; pg8::gemm_phase<EpiSwiglu, pg8::StaticOrder, true, true>(L, g, S, E); }
    grid.sync();
    { pg8::Gemm g{ACT, (const bf16*)(ws + WS_WDN2), NTOK, DM, DFF}; pg8::StaticOrder S; S.init(NTOK, DM, G, (int)blockIdx.x);
      EpiResid E{RES, RES + (size_t)NP * DM, RES, MODS, 8, 0.5f}; pg8::gemm_phase<EpiResid, pg8::StaticOrder, true, true>(L, g, S, E); }
    grid.sync();
    phase_final_norm(RES, A.final_norm, gw, NGW, lane);
}

extern "C" void kernel_launch(void* const* d_in, const int* in_sizes, int n_in, void* d_out, int out_size, void* d_ws, size_t ws_size, hipStream_t stream) {
    static int grid = 0;
    if (grid == 0) {
        if (n_in != 23 || ws_size < WS_END) { fprintf(stderr, "kernel_launch: unexpected n_in %d / ws %zu\n", n_in, ws_size); grid = -1; return; }
        int dev = 0, cus = 0, per_cu = 0;
        hipGetDevice(&dev);
        hipDeviceGetAttribute(&cus, hipDeviceAttributeMultiprocessorCount, dev);
        if (hipFuncSetAttribute((const void*)mega_fwd, hipFuncAttributeMaxDynamicSharedMemorySize, LDS_BYTES) != hipSuccess) { fprintf(stderr, "kernel_launch: hipFuncSetAttribute failed\n"); grid = -1; return; }
        hipOccupancyMaxActiveBlocksPerMultiprocessor(&per_cu, (const void*)mega_fwd, 512, LDS_BYTES);
        if (per_cu < 1) per_cu = 1;
        (void)hipGetLastError();
        grid = cus;
        if (grid > 256) grid = 256;
    }
    if (grid < 0) return;
    Args a{};
    const float** p = (const float**)&a;
    for (int i = 0; i < 23; ++i) p[i] = (const float*)d_in[i];
    a.out = (float*)d_out; a.ws = (unsigned char*)d_ws;
    void* args[] = {&a};
    hipError_t e = hipLaunchCooperativeKernel((const void*)mega_fwd, dim3(grid), dim3(512), args, LDS_BYTES, stream);
    if (e != hipSuccess) fprintf(stderr, "cooperative launch failed: %s (grid %d)\n", hipGetErrorString(e), grid);
}
```

```cpp
#include <hip/hip_runtime.h>
#include <hip/hip_cooperative_groups.h>
#include <cstdio>
#include <cstdint>
namespace cg = cooperative_groups;
namespace pg8 {
#define PG8_LAS __attribute__((address_space(3)))
typedef unsigned short bf16_t;
typedef short bf16x8 __attribute__((ext_vector_type(8)));
typedef float f32x4 __attribute__((ext_vector_type(4)));
typedef unsigned u32x4 __attribute__((ext_vector_type(4)));
constexpr int BM = 256, BK = 64, HALF = 128, HTB = HALF * BK * 2  , STAGE_BYTES = 8 * HTB, NXCD = 8, WGM = 8;

__host__ __device__ __forceinline__ int lds_byte(int r, int c) { const int st = (r >> 4) * 2 + (c >> 5), rr = r & 15, cc = c & 31, ob = rr * 64 + cc * 2; return st * 1024 + (ob ^ (((ob >> 9) & 1) << 5)); }
__host__ __device__ __forceinline__ void stage_rc(int b, int& R, int& C) { const int st = b / 1024, sb = b % 1024, swz = sb ^ (((sb >> 9) & 1) << 5); R = (st >> 1) * 16 + swz / 64; C = (st & 1) * 32 + (swz % 64) / 2; }
__host__ __device__ __forceinline__ int perm32(int rho) { const int n = rho >> 4, i = rho & 15; return 8 * (i >> 2) + 4 * n + (i & 3); }

struct Unit { int pm, pn; };
struct Gemm { const bf16_t* A; const bf16_t* Bt; int M, N, K; };

struct StaticOrder {
    int nM, nN, nwg, G, c;
    __host__ __device__ void init(int M, int N, int G_, int c_) { nM = M / BM; nN = N / BM; nwg = nM * nN; G = G_; c = c_; }
    __host__ __device__ bool next(int i, Unit& u) const {
        const long L = (long)i * G + c; if (L >= nwg) return false;
        int wgid = (int)L; { const int q = nwg / NXCD, r = nwg % NXCD, xcd = wgid % NXCD, off = wgid / NXCD; wgid = (xcd < r ? xcd * (q + 1) : r * (q + 1) + (xcd - r) * q) + off; }
        const int nig = WGM * nN, gid = wgid / nig, fm = gid * WGM, gsz = (nM - fm) < WGM ? (nM - fm) : WGM;
        u.pm = fm + ((wgid % nig) % gsz); u.pn = (wgid % nig) / gsz; return true;
    }
    __device__ __forceinline__ void a_ready(const Unit&) const {}
    __device__ __forceinline__ void done(const Unit&) const {}
};

__device__ __forceinline__ unsigned cvt_pk_bf16(float lo, float hi) { unsigned r; asm volatile("v_cvt_pk_bf16_f32 %0, %1, %2" : "=v"(r) : "v"(lo), "v"(hi)); return r; }
typedef float f32x2 __attribute__((ext_vector_type(2)));
__device__ __forceinline__ f32x2 gelu_pk(f32x2 v) {
    const f32x2 av = __builtin_elementwise_abs(v), d = av * 0.2316418882f + 1.0f;
    f32x2 t; t.x = __builtin_amdgcn_rcpf(d.x); t.y = __builtin_amdgcn_rcpf(d.y);
    f32x2 q = t * 0.5307027145f + (-0.7265760135f); q = q * t + 0.7107068705f; q = q * t + (-0.142248368f); q = q * t + 0.127414796f; q = q * t;
    const f32x2 s = (v * v) * (-0.72134752044f);
    f32x2 e; e.x = __builtin_amdgcn_exp2f(s.x); e.y = __builtin_amdgcn_exp2f(s.y);
    const f32x2 m = v * (q * e), r = v - m;
    f32x2 o; o.x = v.x < 0.f ? m.x : r.x; o.y = v.y < 0.f ? m.y : r.y; return o;
}

template <int ACT  > struct EpiBf16 {
    static constexpr bool PERM = true, AFTER_DRAIN = false; static_assert(ACT == 0 || ACT == 1, "EpiBf16: ACT is 0 (none) or 1 (gelu_pk)");
    bf16_t* O; int ldc; const float* bias; int split_cols; size_t split_stride; float scale0;
    __device__ __forceinline__ void operator()(const f32x4 (&acc)[2][2][4][2], const Unit& u, int wr, int wc, int fr, int fq) const {
        const int row0 = u.pm * BM + wr * 64 + fr; int colt = u.pn * BM; bf16_t* base = O;
        float sc = 1.f; if (split_cols) { const int t = colt / split_cols; base += (size_t)t * split_stride; colt -= t * split_cols; if (t == 0) sc = scale0; }
        const int col0 = colt + wc * 32 + 8 * fq, bcol0 = u.pn * BM + wc * 32 + 8 * fq;
        f32x4 bv[2][2];
#pragma unroll
        for (int bj = 0; bj < 2; ++bj)
#pragma unroll
            for (int n = 0; n < 2; ++n) bv[bj][n] = bias ? *(const f32x4*)(bias + bcol0 + bj * HALF + 4 * n) : (f32x4){0.f, 0.f, 0.f, 0.f};
#pragma unroll
        for (int ai = 0; ai < 2; ++ai)
#pragma unroll
            for (int m = 0; m < 4; ++m) { bf16_t* rowp = base + (size_t)(row0 + ai * HALF + m * 16) * ldc + col0;
#pragma unroll
                for (int bj = 0; bj < 2; ++bj) { f32x4 v0 = acc[ai][bj][m][0] + bv[bj][0], v1 = acc[ai][bj][m][1] + bv[bj][1];
                    if (ACT == 1) { f32x2 a = gelu_pk((f32x2){v0[0], v0[1]}), b = gelu_pk((f32x2){v0[2], v0[3]}), c = gelu_pk((f32x2){v1[0], v1[1]}), d = gelu_pk((f32x2){v1[2], v1[3]});
                        v0 = (f32x4){a.x, a.y, b.x, b.y}; v1 = (f32x4){c.x, c.y, d.x, d.y}; }
                    v0 = v0 * sc; v1 = v1 * sc; u32x4 w; w.x = cvt_pk_bf16(v0[0], v0[1]); w.y = cvt_pk_bf16(v0[2], v0[3]); w.z = cvt_pk_bf16(v1[0], v1[1]); w.w = cvt_pk_bf16(v1[2], v1[3]);
                    *(u32x4*)(rowp + bj * HALF) = w; } }
    }
};

template <class Epi, class Sched, bool ALIGN_EPI = false, bool SP2 = false>
__device__ __forceinline__ void gemm_phase(PG8_LAS unsigned char* lds, const Gemm g, const Sched& S, const Epi& E) {
    const int tid = threadIdx.x, wid = __builtin_amdgcn_readfirstlane(tid >> 6), lane = tid & 63, wr = wid >> 2, wc = wid & 3, fr = lane & 15, fq = lane >> 4;
    const int K = g.K, nt = K / BK;
    unsigned voffA[2], voffB[2];
#pragma unroll
    for (int i = 0; i < 2; ++i) { int R, C; stage_rc(tid * 16 + i * 8192, R, C); const int Rb = Epi::PERM ? ((R & ~31) + perm32(R & 31)) : R;
        voffA[i] = (unsigned)(R * K + C) * 2u; voffB[i] = (unsigned)(Rb * K + C) * 2u; }
    const size_t kstep = (size_t)(BK * 2);
    const size_t hstep = (size_t)HALF * K * 2;
    const size_t tstep = 2 * hstep;
    const unsigned ldsw = (unsigned)wid * 1024u;
    const int aoff = lds_byte(wr * 64 + fr, fq * 8), boff = lds_byte(wc * 32 + fr, fq * 8);
#define PG8_SA(b, h) (((b) * 2 + (h)) * HTB)
#define PG8_SB(b, h) ((4 + (b) * 2 + (h)) * HTB)
#define PG8_STAGE(bufoff, gbase, voff) do { _Pragma("unroll") for (int _i = 0; _i < 2; ++_i) \
        __builtin_amdgcn_global_load_lds((const unsigned*)((const char*)(gbase) + (voff)[_i]), (PG8_LAS unsigned*)(lds + (bufoff) + ldsw + _i * 8192), 16, 0, 0); } while (0)
#define PG8_LDA(dst, b, h) do { _Pragma("unroll") for (int m = 0; m < 4; ++m) _Pragma("unroll") for (int k = 0; k < 2; ++k) dst[m][k] = *(const PG8_LAS bf16x8*)(lds + PG8_SA(b, h) + aoff + m * 2048 + k * 1024); } while (0)
#define PG8_LDB(dst, b, h) do { _Pragma("unroll") for (int n = 0; n < 2; ++n) _Pragma("unroll") for (int k = 0; k < 2; ++k) dst[n][k] = *(const PG8_LAS bf16x8*)(lds + PG8_SB(b, h) + boff + n * 2048 + k * 1024); } while (0)
#define PG8_MMA(ai, bj, At, Bt) do { __builtin_amdgcn_s_setprio(1); _Pragma("unroll") for (int m = 0; m < 4; ++m) _Pragma("unroll") for (int n = 0; n < 2; ++n) _Pragma("unroll") for (int k = 0; k < 2; ++k) \
        acc[ai][bj][m][n] = __builtin_amdgcn_mfma_f32_16x16x32_bf16(Bt[n][k], At[m][k], acc[ai][bj][m][n], 0, 0, 0); __builtin_amdgcn_s_setprio(0); } while (0)
#define PG8_WAIT_V(n) asm volatile("s_waitcnt vmcnt(" #n ")" ::: "memory")
#define PG8_WAIT_L(n) asm volatile("s_waitcnt lgkmcnt(" #n ")" ::: "memory")
#define PG8_BAR __builtin_amdgcn_s_barrier()
#define PG8_SCHED __builtin_amdgcn_sched_barrier(0)
    Unit cur, nxt; int ui = 0;
    if (!S.next(0, cur)) return;
    f32x4 acc[2][2][4][2];
#pragma unroll
    for (int a = 0; a < 2; ++a)
#pragma unroll
        for (int b = 0; b < 2; ++b)
#pragma unroll
            for (int m = 0; m < 4; ++m)
#pragma unroll
                for (int n = 0; n < 2; ++n) acc[a][b][m][n] = (f32x4){0.f, 0.f, 0.f, 0.f};
    bf16x8 At[4][2], B0[2][2], B1[2][2];
    const char* cA = (const char*)g.A + (size_t)cur.pm * tstep; const char* cB = (const char*)g.Bt + (size_t)cur.pn * tstep;
    S.a_ready(cur);
    if constexpr (SP2) {
        PG8_STAGE(PG8_SB(0, 0), cB, voffB); PG8_STAGE(PG8_SB(0, 1), cB + hstep, voffB); PG8_STAGE(PG8_SA(0, 0), cA, voffA); PG8_STAGE(PG8_SA(0, 1), cA + hstep, voffA);
        if (wr == 1) PG8_BAR;
        PG8_WAIT_V(2); PG8_BAR;
        PG8_STAGE(PG8_SB(1, 0), cB + kstep, voffB); PG8_STAGE(PG8_SA(1, 0), cA + kstep, voffA); PG8_STAGE(PG8_SB(1, 1), cB + hstep + kstep, voffB);
        PG8_WAIT_V(6); PG8_BAR;
    } else {
        PG8_STAGE(PG8_SB(0, 0), cB, voffB); PG8_STAGE(PG8_SA(0, 0), cA, voffA); PG8_STAGE(PG8_SB(0, 1), cB + hstep, voffB); PG8_STAGE(PG8_SA(0, 1), cA + hstep, voffA);
        if (wr == 1) PG8_BAR;
        PG8_WAIT_V(4); PG8_BAR;
        PG8_STAGE(PG8_SB(1, 0), cB + kstep, voffB); PG8_STAGE(PG8_SA(1, 0), cA + kstep, voffA); PG8_STAGE(PG8_SB(1, 1), cB + hstep + kstep, voffB);
        PG8_WAIT_V(6); PG8_BAR;
    }
    for (;;) {
        const bool has_next = S.next(ui + 1, nxt);
        const char* nA = has_next ? (const char*)g.A + (size_t)nxt.pm * tstep : cA; const char* nB = has_next ? (const char*)g.Bt + (size_t)nxt.pn * tstep : cB;
        for (int t = 0; t < nt; t += 2) {
            const bool last = (t == nt - 2);
            const char* a1 = cA + (size_t)(t + 1) * kstep;
            const char* a2 = last ? nA : cA + (size_t)(t + 2) * kstep; const char* b2 = last ? nB : cB + (size_t)(t + 2) * kstep;
            const char* a3 = a2 + kstep; const char* b3 = b2 + kstep;
            if (last && has_next) S.a_ready(nxt);
            if constexpr (SP2) {
            PG8_LDB(B0, 0, 0); PG8_LDB(B1, 0, 1); PG8_SCHED; PG8_LDA(At, 0, 0); PG8_STAGE(PG8_SA(1, 1), a1 + hstep, voffA);
            PG8_WAIT_V(8); PG8_WAIT_L(0); PG8_BAR; PG8_MMA(0, 0, At, B0); PG8_MMA(0, 1, At, B1); PG8_BAR; PG8_SCHED;
            PG8_LDA(At, 0, 1); PG8_STAGE(PG8_SB(0, 0), b2, voffB); PG8_STAGE(PG8_SB(0, 1), b2 + hstep, voffB); PG8_STAGE(PG8_SA(0, 0), a2, voffA);
            PG8_WAIT_V(8); PG8_WAIT_L(0); PG8_BAR; PG8_MMA(1, 0, At, B0); PG8_MMA(1, 1, At, B1); PG8_BAR; PG8_SCHED;
            PG8_LDB(B0, 1, 0); PG8_LDB(B1, 1, 1); PG8_SCHED; PG8_LDA(At, 1, 0); PG8_STAGE(PG8_SA(0, 1), a2 + hstep, voffA);
            PG8_WAIT_V(8); PG8_WAIT_L(0); PG8_BAR; PG8_MMA(0, 0, At, B0); PG8_MMA(0, 1, At, B1); PG8_BAR; PG8_SCHED;
            PG8_LDA(At, 1, 1); PG8_STAGE(PG8_SB(1, 0), b3, voffB); PG8_STAGE(PG8_SB(1, 1), b3 + hstep, voffB); PG8_STAGE(PG8_SA(1, 0), a3, voffA);
            PG8_WAIT_V(8); PG8_WAIT_L(0); PG8_BAR; PG8_MMA(1, 0, At, B0); PG8_MMA(1, 1, At, B1); PG8_BAR; PG8_SCHED;
            } else {
            PG8_LDB(B0, 0, 0); PG8_SCHED; PG8_LDA(At, 0, 0); PG8_STAGE(PG8_SA(1, 1), a1 + hstep, voffA);
            PG8_WAIT_L(8); PG8_BAR; PG8_WAIT_L(0); PG8_MMA(0, 0, At, B0); PG8_BAR; PG8_SCHED;
            PG8_LDB(B1, 0, 1); PG8_STAGE(PG8_SB(0, 0), b2, voffB);
            PG8_BAR; PG8_WAIT_L(0); PG8_MMA(0, 1, At, B1); PG8_BAR;
            PG8_LDA(At, 0, 1); PG8_STAGE(PG8_SA(0, 0), a2, voffA);
            PG8_BAR; PG8_WAIT_L(0); PG8_MMA(1, 0, At, B0); PG8_BAR; PG8_SCHED;
            PG8_STAGE(PG8_SB(0, 1), b2 + hstep, voffB);
            PG8_WAIT_V(6); PG8_BAR; PG8_MMA(1, 1, At, B1); PG8_BAR;
            PG8_LDB(B0, 1, 0); PG8_SCHED; PG8_LDA(At, 1, 0); PG8_STAGE(PG8_SA(0, 1), a2 + hstep, voffA);
            PG8_WAIT_L(8); PG8_BAR; PG8_WAIT_L(0); PG8_MMA(0, 0, At, B0); PG8_BAR; PG8_SCHED;
            PG8_LDB(B1, 1, 1); PG8_STAGE(PG8_SB(1, 0), b3, voffB);
            PG8_BAR; PG8_WAIT_L(0); PG8_MMA(0, 1, At, B1); PG8_BAR;
            PG8_LDA(At, 1, 1); PG8_STAGE(PG8_SA(1, 0), a3, voffA);
            PG8_BAR; PG8_WAIT_L(0); PG8_MMA(1, 0, At, B0); PG8_BAR; PG8_SCHED;
            PG8_STAGE(PG8_SB(1, 1), b3 + hstep, voffB);
            PG8_WAIT_V(6); PG8_BAR; PG8_MMA(1, 1, At, B1); PG8_BAR;
            }
        }
        if constexpr (ALIGN_EPI) { if (wr == 0) PG8_BAR; }
        if constexpr (!Epi::AFTER_DRAIN) { E(acc, cur, wr, wc, fr, fq); S.done(cur); }
        if (!has_next) break;
#pragma unroll
        for (int a = 0; a < 2; ++a)
#pragma unroll
            for (int b = 0; b < 2; ++b)
#pragma unroll
                for (int m = 0; m < 4; ++m)
#pragma unroll
                    for (int n = 0; n < 2; ++n) acc[a][b][m][n] = (f32x4){0.f, 0.f, 0.f, 0.f};
        cur = nxt; cA = nA; cB = nB; ++ui;
        if constexpr (ALIGN_EPI) { if (wr == 1) PG8_BAR; }
    }
    PG8_WAIT_V(0);
    if constexpr (!ALIGN_EPI) { if (wr == 0) PG8_BAR; }
    PG8_BAR;
    if constexpr (Epi::AFTER_DRAIN) { E.fused(acc, cur, wr, wc, fr, fq, lds, wid, lane); S.done(cur); }
#undef PG8_SA
#undef PG8_SB
#undef PG8_STAGE
#undef PG8_LDA
#undef PG8_LDB
#undef PG8_MMA
#undef PG8_WAIT_V
#undef PG8_WAIT_L
#undef PG8_BAR
#undef PG8_SCHED
}
}

#define GAS __attribute__((address_space(1)))
#define LAS __attribute__((address_space(3)))
typedef unsigned short bf16;
typedef unsigned v4u __attribute__((ext_vector_type(4)));
typedef unsigned v2u __attribute__((ext_vector_type(2)));
typedef float f32x4 __attribute__((ext_vector_type(4)));
typedef short bf16x8 __attribute__((ext_vector_type(8)));

constexpr int NTOK = 16384, NP = 8192, DM = 1024, DFF = 2816, NIN = 3104, NINP = 3328;
constexpr int NMOD = 9, NMODROW = 5;
constexpr float EPS = 1e-6f;
constexpr int PC_Q = 0, PC_K = 256, PC_V = 512, PC_G = 1024, PC_LR = 1536, PC_CB = 1568, PC_CC = 2080, PC_CH = 2592;

constexpr size_t MiB = 1u << 20;
constexpr size_t WS_MODS = 0;
constexpr size_t WS_BAR = 512 * 1024;
constexpr size_t WS_WUP1 = 1 * MiB, WS_WDN1 = 12 * MiB, WS_WIN = 18 * MiB, WS_WOUT = 25 * MiB, WS_WUP2 = 27 * MiB, WS_WDN2 = 38 * MiB;
constexpr size_t WS_H = 44 * MiB;
constexpr size_t WS_PROJ = 76 * MiB;
constexpr size_t WS_STATE = 180 * MiB;
constexpr size_t WS_TOT = 244 * MiB;
constexpr size_t WS_END = 245 * MiB;
constexpr int LDS_BYTES = 147456;
#ifndef REP_SYNC
#define REP_SYNC 1
#endif
#ifndef REP_P0
#define REP_P0 1
#endif
#ifndef REP_GLA
#define REP_GLA 1
#endif
#ifndef REP_NORM
#define REP_NORM 1
#endif
#define GSYNC() do { for (int r_ = 0; r_ < REP_SYNC; ++r_) { XcdBarrier xb_; xb_.bar = (unsigned*)(A.ws + WS_BAR); xb_.x = xb_xcc_id(); xb_.st = (volatile LAS unsigned*)(L + 140000); xcd_barrier(xb_); } } while (0)

__device__ __forceinline__ float bf2f(unsigned b) { return __uint_as_float(b << 16); }
__device__ __forceinline__ float bflo(unsigned w) { return __uint_as_float(w << 16); }
__device__ __forceinline__ float bfhi(unsigned w) { return __uint_as_float(w & 0xffff0000u); }
__device__ __forceinline__ unsigned pk2(float lo, float hi) { return pg8::cvt_pk_bf16(lo, hi); }
__device__ __forceinline__ float wave_sum(float v) {
#pragma unroll
    for (int o = 1; o < 64; o <<= 1) v += __shfl_xor(v, o);
    return v;
}
__device__ __forceinline__ float silu_f(float g) { return g * __builtin_amdgcn_rcpf(1.f + __expf(-g)); }

struct EpiSwiglu {
    static constexpr bool PERM = true, AFTER_DRAIN = false;
    bf16* O; int ldc;
    __device__ __forceinline__ void operator()(const pg8::f32x4 (&acc)[2][2][4][2], const pg8::Unit& u, int wr, int wc, int fr, int fq) const {
        const int row0 = u.pm * 256 + wr * 64 + fr, col0 = u.pn * 128 + wc * 32 + 8 * fq;
#pragma unroll
        for (int ai = 0; ai < 2; ++ai)
#pragma unroll
            for (int m = 0; m < 4; ++m) {
                bf16* rowp = O + (size_t)(row0 + ai * 128 + m * 16) * ldc + col0;
                const pg8::f32x4 g0 = acc[ai][0][m][0], g1 = acc[ai][0][m][1], u0 = acc[ai][1][m][0], u1 = acc[ai][1][m][1];
                v4u w;
                w.x = pk2(silu_f(g0[0]) * u0[0], silu_f(g0[1]) * u0[1]);
                w.y = pk2(silu_f(g0[2]) * u0[2], silu_f(g0[3]) * u0[3]);
                w.z = pk2(silu_f(g1[0]) * u1[0], silu_f(g1[1]) * u1[1]);
                w.w = pk2(silu_f(g1[2]) * u1[2], silu_f(g1[3]) * u1[3]);
                *(v4u*)rowp = w;
            }
    }
};
struct EpiResid {
    static constexpr bool PERM = true, AFTER_DRAIN = false;
    const float* base0; const float* base1; float* out; const float* mods; int modrow; float scale;
    __device__ __forceinline__ void operator()(const pg8::f32x4 (&acc)[2][2][4][2], const pg8::Unit& u, int wr, int wc, int fr, int fq) const {
        const int mi = u.pm < 32 ? 0 : 1 + ((u.pm - 32) >> 3);
        const float* mrow = mods + (size_t)(mi * NMOD + modrow) * DM;
        const int row0 = u.pm * 256 + wr * 64 + fr, col0 = u.pn * 256 + wc * 32 + 8 * fq;
        f32x4 mv[2][2];
#pragma unroll
        for (int bj = 0; bj < 2; ++bj)
#pragma unroll
            for (int n = 0; n < 2; ++n) mv[bj][n] = *(const f32x4*)(mrow + col0 + bj * 128 + 4 * n) * scale;
#pragma unroll
        for (int ai = 0; ai < 2; ++ai)
#pragma unroll
            for (int m = 0; m < 4; ++m) {
                const int row = row0 + ai * 128 + m * 16;
                const float* bp = (row < NP ? base0 + (size_t)row * DM : base1 + (size_t)(row - NP) * DM) + col0;
                float* op = out + (size_t)row * DM + col0;
#pragma unroll
                for (int bj = 0; bj < 2; ++bj)
#pragma unroll
                    for (int n = 0; n < 2; ++n) {
                        const f32x4 b = *(const f32x4*)(bp + bj * 128 + 4 * n);
                        *(f32x4*)(op + bj * 128 + 4 * n) = b + mv[bj][n] * acc[ai][bj][m][n];
                    }
            }
    }
};

__device__ __forceinline__ void phase_mods(LAS unsigned char* L, const float* c, const float* c_ctx, const float* w_ada, const float* b_ada, float* MODS, int tid) {
    LAS float* SC = (LAS float*)L;
    LAS float* RED = (LAS float*)(L + 20480);
    for (int i = tid; i < NMODROW * DM; i += 512) { const int j = i >> 10, k = i & 1023; const float v = j == 0 ? c_ctx[k] : c[(j - 1) * DM + k]; SC[i] = v / (1.f + expf(-v)); }
    __syncthreads();
    for (int cb = blockIdx.x; cb < 256; cb += gridDim.x) {
        const int n0 = cb * 36;
        if (tid < 504) {
            const int ci = tid % 36, kg = tid / 36;
            float a0 = 0.f, a1 = 0.f, a2 = 0.f, a3 = 0.f, a4 = 0.f;
#pragma unroll 8
            for (int k = kg; k < DM; k += 14) {
                const float w = w_ada[(size_t)k * (NMOD * DM) + n0 + ci];
                a0 += SC[k] * w; a1 += SC[DM + k] * w; a2 += SC[2 * DM + k] * w; a3 += SC[3 * DM + k] * w; a4 += SC[4 * DM + k] * w;
            }
            LAS float* r = RED + (kg * 36 + ci) * 5; r[0] = a0; r[1] = a1; r[2] = a2; r[3] = a3; r[4] = a4;
        }
        __syncthreads();
        if (tid < 180) {
            const int ci = tid % 36, j = tid / 36; float s = b_ada[n0 + ci];
#pragma unroll
            for (int kg = 0; kg < 14; ++kg) s += RED[(kg * 36 + ci) * 5 + j];
            MODS[(size_t)j * (NMOD * DM) + n0 + ci] = s;
        }
        __syncthreads();
    }
}
__device__ __forceinline__ void transpose_item(const float* W, int K, int N, bf16* WT, int k0, int n0, int drow0, LAS float* scr, int lane) {
#pragma unroll 8
    for (int i = 0; i < 32; ++i) { const int kk = 2 * i + (lane >> 5); scr[kk * 33 + (lane & 31)] = W[(size_t)(k0 + kk) * N + n0 + (lane & 31)]; }
    asm volatile("s_waitcnt lgkmcnt(0)" ::: "memory");
    const int c = lane & 7;
#pragma unroll
    for (int j = 0; j < 4; ++j) { const int n = (lane >> 3) + 8 * j; const LAS float* s = scr + (8 * c) * 33 + n;
        v4u o; o.x = pk2(s[0 * 33], s[1 * 33]); o.y = pk2(s[2 * 33], s[3 * 33]); o.z = pk2(s[4 * 33], s[5 * 33]); o.w = pk2(s[6 * 33], s[7 * 33]);
        *(v4u*)(WT + (size_t)(drow0 + n) * K + k0 + 8 * c) = o; }
    asm volatile("s_waitcnt lgkmcnt(0)" ::: "memory");
}
struct WPtrs { const float *w1a, *w3a, *w2a, *win, *wout, *w1b, *w3b, *w2b; };
__device__ __forceinline__ void phase_weights(LAS unsigned char* L, const WPtrs& W, unsigned char* ws, int gw, int NGW, int wave, int lane, int gtid, int nthr) {
    LAS float* scr = (LAS float*)(L + 32768 + wave * 8704);
    constexpr int I_UP = 16 * 88, I_DN = 44 * 32, I_IN = 16 * 97, I_OUT = 16 * 32;
    constexpr int NITEMS = 4 * I_UP + 2 * I_DN + I_IN + I_OUT;
    for (int it = gw; it < NITEMS; it += NGW) {
        int r = it;
        if (r < 4 * I_UP) {
            const int which = r / I_UP; r -= which * I_UP; const int kb = r / 88, nb = r % 88, n0 = nb * 32;
            const float* src = which == 0 ? W.w1a : which == 1 ? W.w3a : which == 2 ? W.w1b : W.w3b;
            bf16* dst = (bf16*)(ws + (which < 2 ? WS_WUP1 : WS_WUP2));
            transpose_item(src, DM, DFF, dst, kb * 64, n0, (n0 >> 7) * 256 + (which & 1) * 128 + (n0 & 127), scr, lane); continue; }
        r -= 4 * I_UP;
        if (r < 2 * I_DN) { const int which = r / I_DN; r -= which * I_DN; const int kb = r / 32, nb = r % 32;
            transpose_item(which == 0 ? W.w2a : W.w2b, DFF, DM, (bf16*)(ws + (which == 0 ? WS_WDN1 : WS_WDN2)), kb * 64, nb * 32, nb * 32, scr, lane); continue; }
        r -= 2 * I_DN;
        if (r < I_IN) { const int kb = r / 97, nb = r % 97; transpose_item(W.win, DM, NIN, (bf16*)(ws + WS_WIN), kb * 64, nb * 32, nb * 32, scr, lane); continue; }
        r -= I_IN;
        { const int kb = r / 32, nb = r % 32; transpose_item(W.wout, DM, DM, (bf16*)(ws + WS_WOUT), kb * 64, nb * 32, nb * 32, scr, lane); }
    }
    v4u* z = (v4u*)(ws + WS_WIN + (size_t)NIN * DM * 2);
    for (int i = gtid; i < (NINP - NIN) * DM / 8; i += nthr) z[i] = (v4u){0u, 0u, 0u, 0u};
}

__device__ __forceinline__ void phase_normmod(const float* x0, const float* x1, const float* gain, const float* MODS, int i_shift, int i_scale, bf16* H, int gw, int NGW, int lane) {
    for (int m = gw; m < NTOK; m += NGW) {
        const float* xrow = m < NP ? x0 + (size_t)m * DM : x1 + (size_t)(m - NP) * DM;
        const int mi = m < NP ? 0 : 1 + ((m - NP) >> 11);
        const f32x4* xr = (const f32x4*)xrow + lane;
        const f32x4* gp = (const f32x4*)gain + lane;
        const f32x4* sh = (const f32x4*)(MODS + (size_t)(mi * NMOD + i_shift) * DM) + lane;
        const f32x4* sc = (const f32x4*)(MODS + (size_t)(mi * NMOD + i_scale) * DM) + lane;
        f32x4 v[4]; float s = 0.f;
#pragma unroll
        for (int j = 0; j < 4; ++j) { v[j] = xr[64 * j]; s += (v[j].x * v[j].x + v[j].y * v[j].y) + (v[j].z * v[j].z + v[j].w * v[j].w); }
        const float rstd = rsqrtf(wave_sum(s) * (1.f / DM) + EPS);
        unsigned long long* o8 = (unsigned long long*)(H + (size_t)m * DM) + lane;
#pragma unroll
        for (int j = 0; j < 4; ++j) {
            const f32x4 g = gp[64 * j], a = sc[64 * j], b = sh[64 * j];
            const f32x4 y = (v[j] * rstd * g) * (a + 1.f) + b;
            o8[64 * j] = (unsigned long long)pk2(y.x, y.y) | ((unsigned long long)pk2(y.z, y.w) << 32);
        }
    }
}
__device__ __forceinline__ void phase_final_norm(float* X, const float* gain, int gw, int NGW, int lane) {
    for (int m = gw; m < NTOK; m += NGW) {
        f32x4* xr = (f32x4*)(X + (size_t)m * DM) + lane;
        const f32x4* gp = (const f32x4*)gain + lane;
        f32x4 v[4]; float s = 0.f;
#pragma unroll
        for (int j = 0; j < 4; ++j) { v[j] = xr[64 * j]; s += (v[j].x * v[j].x + v[j].y * v[j].y) + (v[j].z * v[j].z + v[j].w * v[j].w); }
        const float rstd = rsqrtf(wave_sum(s) * (1.f / DM) + EPS);
#pragma unroll
        for (int j = 0; j < 4; ++j) xr[64 * j] = v[j] * rstd * gp[64 * j];
    }
}

constexpr int G_LR = 0, G_WD = 8192, G_BD = 16384, G_PT = 16896, G_CUM = 18944;
constexpr int G_QK = 51712;
constexpr int G_VT = 88576;
constexpr int G_SC = 107008;
constexpr int G_SSQ = 116224;
constexpr int G_ST = 0;
constexpr int RS = 72;

__device__ __forceinline__ void gla_cum(LAS unsigned char* L, const bf16* PROJ, const float* w_decay, const float* b_decay, int row0, int h, int tid) {
    LAS float* LR = (LAS float*)(L + G_LR); LAS float* WD = (LAS float*)(L + G_WD); LAS float* BD = (LAS float*)(L + G_BD);
    LAS float* PT = (LAS float*)(L + G_PT); LAS float* CUM = (LAS float*)(L + G_CUM);
    { const int t = tid >> 3, part = tid & 7;
      const v2u raw = *(const v2u*)(PROJ + (size_t)(row0 + t) * NINP + PC_LR + 4 * part);
      LAS float* dst = LR + ((part >> 2) * 64 + t) * 16 + (part & 3) * 4;
      dst[0] = bflo(raw.x); dst[1] = bfhi(raw.x); dst[2] = bflo(raw.y); dst[3] = bfhi(raw.y); }
    { const int idx = tid * 4, dir = idx >> 10, j = (idx >> 6) & 15, d = idx & 63;
      *(LAS f32x4*)(WD + idx) = *(const f32x4*)(w_decay + dir * 4096 + j * 256 + h * 64 + d); }
    if (tid < 128) BD[tid] = b_decay[(tid >> 6) * 256 + h * 64 + (tid & 63)];
    __syncthreads();
    const int d = tid & 63, dir = (tid >> 6) & 1, part = tid >> 7;
    {
        float wreg[16];
#pragma unroll
        for (int j = 0; j < 16; ++j) wreg[j] = WD[dir * 1024 + j * 64 + d];
        const float bias = BD[dir * 64 + d];
        float run = 0.f;
#pragma unroll
        for (int i = 0; i < 16; ++i) {
            const int t = dir == 0 ? part * 16 + i : part * 16 + 15 - i;
            const LAS float* lr = LR + (dir * 64 + t) * 16;
            float x = bias;
#pragma unroll
            for (int j = 0; j < 16; ++j) x += lr[j] * wreg[j];
            const float la = (fminf(x, 0.f) - log1pf(expf(-fabsf(x)))) * (1.f / 16.f);
            run += la; CUM[(dir * 64 + t) * 64 + d] = run;
        }
        PT[(dir * 4 + part) * 64 + d] = run;
    }
    __syncthreads();
    {
        float off = 0.f;
#pragma unroll
        for (int p = 0; p < 4; ++p) { const float v = PT[(dir * 4 + p) * 64 + d]; if (dir == 0 ? p < part : p > part) off += v; }
#pragma unroll
        for (int i = 0; i < 16; ++i) CUM[(dir * 64 + part * 16 + i) * 64 + d] += off;
    }
    __syncthreads();
}
__device__ __forceinline__ void gla_load_vt(LAS unsigned char* L, const bf16* PROJ, int row0, int h, int tid) {
    LAS bf16* VT = (LAS bf16*)(L + G_VT);
    const int s = tid >> 3, e0 = (tid & 7) * 16;
    const v4u* src = (const v4u*)(PROJ + (size_t)(row0 + s) * NINP + PC_V + h * 128 + e0);
    const v4u a = src[0], b = src[1];
    const unsigned w[8] = {a.x, a.y, a.z, a.w, b.x, b.y, b.z, b.w};
#pragma unroll
    for (int i = 0; i < 8; ++i) { VT[(e0 + 2 * i) * RS + s] = (bf16)(w[i] & 0xffffu); VT[(e0 + 2 * i + 1) * RS + s] = (bf16)(w[i] >> 16); }
}
#define MFMA16(a, b, c) __builtin_amdgcn_mfma_f32_16x16x32_bf16((a), (b), (c), 0, 0, 0)
#define LDFRAG(base, row, kk) (*(const LAS bf16x8*)((base) + (row) * RS + (kk) * 32 + fq * 8))

__device__ __forceinline__ void phase_gla_local(LAS unsigned char* L, const bf16* PROJ, const float* w_decay, const float* b_decay, float* STATE, float* TOT, int tid) {
    const int wave = tid >> 6, lane = tid & 63, fr = lane & 15, fq = lane >> 4;
    LAS float* CUM = (LAS float*)(L + G_CUM); LAS bf16* KT = (LAS bf16*)(L + G_QK); LAS bf16* VT = (LAS bf16*)(L + G_VT);
    for (int unit = blockIdx.x; unit < 1024; unit += gridDim.x) {
        const int gc = unit >> 2, h = unit & 3, row0 = gc * 64;
        gla_cum(L, PROJ, w_decay, b_decay, row0, h, tid);
        { const int s = tid >> 3, d0 = (tid & 7) * 8;
          const v4u kr = *(const v4u*)(PROJ + (size_t)(row0 + s) * NINP + PC_K + h * 64 + d0);
          const unsigned w[4] = {kr.x, kr.y, kr.z, kr.w};
#pragma unroll
          for (int i = 0; i < 8; ++i) {
              const int d = d0 + i; const float k = (i & 1) ? bfhi(w[i >> 1]) : bflo(w[i >> 1]);
              const float tf = CUM[(63) * 64 + d], tb = CUM[(64 + 0) * 64 + d];
              const float cf = CUM[s * 64 + d], cb = CUM[(64 + s) * 64 + d];
              const unsigned pf = pk2(k * expf(tf - cf), 0.f), pb = pk2(k * expf(tb - cb), 0.f);
              KT[(d) * RS + s] = (bf16)(pf & 0xffffu); KT[(64 + d) * RS + s] = (bf16)(pb & 0xffffu);
          } }
        gla_load_vt(L, PROJ, row0, h, tid);
        if (tid < 128) { const int dir = tid >> 6, d = tid & 63; TOT[(size_t)((gc * 4 + h) * 2 + dir) * 64 + d] = dir == 0 ? CUM[63 * 64 + d] : CUM[64 * 64 + d]; }
        __syncthreads();
        { const int dir = wave >> 2, dt = wave & 3;
          const bf16x8 q0 = LDFRAG(KT, dir * 64 + dt * 16 + fr, 0), q1 = LDFRAG(KT, dir * 64 + dt * 16 + fr, 1);
          float* dst = STATE + (size_t)((gc * 4 + h) * 2 + dir) * 8192 + (dt * 16 + fr) * 128 + 4 * fq;
#pragma unroll
          for (int i = 0; i < 8; ++i) {
              const bf16x8 p0 = LDFRAG(VT, i * 16 + fr, 0), p1 = LDFRAG(VT, i * 16 + fr, 1);
              f32x4 acc = {0.f, 0.f, 0.f, 0.f};
              acc = MFMA16(p0, q0, acc); acc = MFMA16(p1, q1, acc);
              *(f32x4*)(dst + i * 16) = acc;
          } }
        __syncthreads();
    }
}

__device__ __forceinline__ void scan_chain(int item, bool sample, float* STATE, const float* TOT, const float* state_in, float* new_state) {
    const int e4 = item & 31, d = (item >> 5) & 63, dir = (item >> 11) & 1, h = (item >> 12) & 3, seq = item >> 14;
    const int N = sample ? 32 : 4, gc0 = sample ? 128 + 32 * seq : 4 * seq;
    f32x4 S = {0.f, 0.f, 0.f, 0.f};
    const size_t sidx = (size_t)((seq * 2 + dir) * 4 + h) * 8192 + d * 128 + e4 * 4;
    if (sample) S = *(const f32x4*)(state_in + sidx);
    for (int st = 0; st < N; st += 4) {
        f32x4 loc[4]; float a[4]; float* p[4];
#pragma unroll
        for (int i = 0; i < 4; ++i) {
            const int c = dir == 0 ? st + i : N - 1 - (st + i); const size_t g = (size_t)((gc0 + c) * 4 + h) * 2 + dir;
            p[i] = STATE + g * 8192 + d * 128 + e4 * 4; loc[i] = *(const f32x4*)p[i]; a[i] = TOT[g * 64 + d];
        }
#pragma unroll
        for (int i = 0; i < 4; ++i) { *(f32x4*)p[i] = S; S = S * expf(a[i]) + loc[i]; }
    }
    if (!sample) *(f32x4*)(new_state + sidx) = S;
}
__device__ __forceinline__ void phase_scan(float* STATE, const float* TOT, const float* state_in, float* new_state, int gtid, int nthr) {
    for (int v = gtid; v < 131072; v += nthr) {
        if (v < 65536) { scan_chain(v, true, STATE, TOT, state_in, new_state); scan_chain(v, false, STATE, TOT, state_in, new_state); }
        else { for (int i = 0; i < 7; ++i) scan_chain(65536 + i * 65536 + (v - 65536), false, STATE, TOT, state_in, new_state); }
    }
}

__device__ __forceinline__ void phase_gla_out(LAS unsigned char* L, const bf16* PROJ, const float* w_decay, const float* b_decay, const float* STATE,
                                              const float* gla_norm, const float* conv_w, bf16* MIX, int tid) {
    const int wave = tid >> 6, lane = tid & 63, fr = lane & 15, fq = lane >> 4;
    LAS float* CUM = (LAS float*)(L + G_CUM);
    LAS bf16* QF = (LAS bf16*)(L + G_QK); LAS bf16* KF = QF + 64 * RS; LAS bf16* QB = KF + 64 * RS; LAS bf16* KB = QB + 64 * RS;
    LAS bf16* VT = (LAS bf16*)(L + G_VT); LAS bf16* SC = (LAS bf16*)(L + G_SC); LAS float* SSQ = (LAS float*)(L + G_SSQ);
    LAS bf16* STF = (LAS bf16*)(L + G_ST); LAS bf16* STB = STF + 128 * RS;
    for (int unit = blockIdx.x; unit < 1024; unit += gridDim.x) {
        const int gc = unit >> 2, h = unit & 3, row0 = gc * 64;
        { const int t = tid >> 3, c0 = 128 * h + (tid & 7) * 16;
          const bool sample = gc >= 128; const int tl = sample ? t : (gc & 3) * 64 + t, Lseg = sample ? 64 : 256;
          const bool hasp = tl > 0, hasn = tl < Lseg - 1;
          const bf16* prow = PROJ + (size_t)(row0 + t) * NINP;
#pragma unroll
          for (int half = 0; half < 2; ++half) {
              const int c = c0 + half * 8;
              const v4u cbv = *(const v4u*)(prow + PC_CB + c);
              const v4u ccm = *(const v4u*)(prow + PC_CC + c), chm = *(const v4u*)(prow + PC_CH + c);
              v4u ccp = {0u, 0u, 0u, 0u}, chp = ccp, ccn = ccp, chn = ccp;
              if (hasp) { ccp = *(const v4u*)(prow - NINP + PC_CC + c); chp = *(const v4u*)(prow - NINP + PC_CH + c); }
              if (hasn) { ccn = *(const v4u*)(prow + NINP + PC_CC + c); chn = *(const v4u*)(prow + NINP + PC_CH + c); }
              const unsigned cbw[4] = {cbv.x, cbv.y, cbv.z, cbv.w}, ccmw[4] = {ccm.x, ccm.y, ccm.z, ccm.w}, chmw[4] = {chm.x, chm.y, chm.z, chm.w};
              const unsigned ccpw[4] = {ccp.x, ccp.y, ccp.z, ccp.w}, chpw[4] = {chp.x, chp.y, chp.z, chp.w}, ccnw[4] = {ccn.x, ccn.y, ccn.z, ccn.w}, chnw[4] = {chn.x, chn.y, chn.z, chn.w};
              unsigned ow[4];
#pragma unroll
              for (int i = 0; i < 4; ++i) {
                  const float w0a = conv_w[c + 2 * i], w1a = conv_w[512 + c + 2 * i], w2a = conv_w[1024 + c + 2 * i];
                  const float w0b = conv_w[c + 2 * i + 1], w1b = conv_w[512 + c + 2 * i + 1], w2b = conv_w[1024 + c + 2 * i + 1];
                  const float lo = bflo(cbw[i]) * (w0a * bflo(ccpw[i]) * bflo(chpw[i]) + w1a * bflo(ccmw[i]) * bflo(chmw[i]) + w2a * bflo(ccnw[i]) * bflo(chnw[i]));
                  const float hi = bfhi(cbw[i]) * (w0b * bfhi(ccpw[i]) * bfhi(chpw[i]) + w1b * bfhi(ccmw[i]) * bfhi(chmw[i]) + w2b * bfhi(ccnw[i]) * bfhi(chnw[i]));
                  ow[i] = pk2(lo, hi);
              }
              *(v4u*)(MIX + (size_t)(row0 + t) * DM + 512 + c) = (v4u){ow[0], ow[1], ow[2], ow[3]};
          } }
        gla_cum(L, PROJ, w_decay, b_decay, row0, h, tid);
        { const int s = tid >> 3, d0 = (tid & 7) * 8;
          const v4u qr = *(const v4u*)(PROJ + (size_t)(row0 + s) * NINP + PC_Q + h * 64 + d0);
          const v4u kr = *(const v4u*)(PROJ + (size_t)(row0 + s) * NINP + PC_K + h * 64 + d0);
          const unsigned qw[4] = {qr.x, qr.y, qr.z, qr.w}, kw[4] = {kr.x, kr.y, kr.z, kr.w};
          unsigned oqf[4], okf[4], oqb[4], okb[4];
#pragma unroll
          for (int i = 0; i < 4; ++i) {
              const int d = d0 + 2 * i;
              const float cf0 = CUM[s * 64 + d], cf1 = CUM[s * 64 + d + 1], cb0 = CUM[(64 + s) * 64 + d], cb1 = CUM[(64 + s) * 64 + d + 1];
              const float q0 = bflo(qw[i]) * 0.125f, q1 = bfhi(qw[i]) * 0.125f, k0 = bflo(kw[i]), k1 = bfhi(kw[i]);
              oqf[i] = pk2(q0 * expf(cf0), q1 * expf(cf1)); okf[i] = pk2(k0 * expf(-cf0), k1 * expf(-cf1));
              oqb[i] = pk2(q0 * expf(cb0), q1 * expf(cb1)); okb[i] = pk2(k0 * expf(-cb0), k1 * expf(-cb1));
          }
          *(LAS v4u*)(QF + s * RS + d0) = (v4u){oqf[0], oqf[1], oqf[2], oqf[3]}; *(LAS v4u*)(KF + s * RS + d0) = (v4u){okf[0], okf[1], okf[2], okf[3]};
          *(LAS v4u*)(QB + s * RS + d0) = (v4u){oqb[0], oqb[1], oqb[2], oqb[3]}; *(LAS v4u*)(KB + s * RS + d0) = (v4u){okb[0], okb[1], okb[2], okb[3]}; }
        gla_load_vt(L, PROJ, row0, h, tid);
        __syncthreads();
#pragma unroll
        for (int dir = 0; dir < 2; ++dir) {
            const float* sp = STATE + (size_t)((gc * 4 + h) * 2 + dir) * 8192;
            LAS bf16* ST = dir == 0 ? STF : STB;
#pragma unroll
            for (int i = 0; i < 2; ++i) {
                const int idx = tid + 512 * i, d2 = idx >> 5, e4 = idx & 31;
                const f32x4 s0 = *(const f32x4*)(sp + (2 * d2) * 128 + e4 * 4), s1 = *(const f32x4*)(sp + (2 * d2 + 1) * 128 + e4 * 4);
#pragma unroll
                for (int r = 0; r < 4; ++r) *(LAS unsigned*)(ST + (e4 * 4 + r) * RS + 2 * d2) = pk2(s0[r], s1[r]);
            }
        }
        { const int tt = wave & 3;
          const bf16x8 qf0 = LDFRAG(QF, tt * 16 + fr, 0), qf1 = LDFRAG(QF, tt * 16 + fr, 1), qb0 = LDFRAG(QB, tt * 16 + fr, 0), qb1 = LDFRAG(QB, tt * 16 + fr, 1);
#pragma unroll
          for (int j = 0; j < 2; ++j) {
              const int st = (wave >> 2) * 2 + j;
              const bf16x8 kf0 = LDFRAG(KF, st * 16 + fr, 0), kf1 = LDFRAG(KF, st * 16 + fr, 1), kb0 = LDFRAG(KB, st * 16 + fr, 0), kb1 = LDFRAG(KB, st * 16 + fr, 1);
              f32x4 af = {0.f, 0.f, 0.f, 0.f}, ab = {0.f, 0.f, 0.f, 0.f};
              af = MFMA16(kf0, qf0, af); af = MFMA16(kf1, qf1, af);
              ab = MFMA16(kb0, qb0, ab); ab = MFMA16(kb1, qb1, ab);
              const int t = tt * 16 + fr, s0 = st * 16 + 4 * fq;
              float v[4];
#pragma unroll
              for (int r = 0; r < 4; ++r) { const int s = s0 + r; v[r] = (s <= t ? af[r] : 0.f) + (s >= t ? ab[r] : 0.f); }
              *(LAS v2u*)(SC + t * RS + s0) = (v2u){pk2(v[0], v[1]), pk2(v[2], v[3])};
          } }
        __syncthreads();
        const int tt = wave & 3, eh = wave >> 2, t = tt * 16 + fr;
        f32x4 o[4]; float ssq = 0.f;
        { const bf16x8 a0 = LDFRAG(SC, t, 0), a1 = LDFRAG(SC, t, 1), b0 = LDFRAG(QF, t, 0), b1 = LDFRAG(QF, t, 1), c0 = LDFRAG(QB, t, 0), c1 = LDFRAG(QB, t, 1);
#pragma unroll
          for (int i4 = 0; i4 < 4; ++i4) {
              const int er = (eh * 4 + i4) * 16 + fr;
              f32x4 acc = {0.f, 0.f, 0.f, 0.f};
              acc = MFMA16(LDFRAG(VT, er, 0), a0, acc); acc = MFMA16(LDFRAG(VT, er, 1), a1, acc);
              acc = MFMA16(LDFRAG(STF, er, 0), b0, acc); acc = MFMA16(LDFRAG(STF, er, 1), b1, acc);
              acc = MFMA16(LDFRAG(STB, er, 0), c0, acc); acc = MFMA16(LDFRAG(STB, er, 1), c1, acc);
              o[i4] = acc; ssq += (acc[0] * acc[0] + acc[1] * acc[1]) + (acc[2] * acc[2] + acc[3] * acc[3]);
          } }
        ssq += __shfl_xor(ssq, 16); ssq += __shfl_xor(ssq, 32);
        if (fq == 0) SSQ[eh * 64 + t] = ssq;
        __syncthreads();
        { const float rstd = rsqrtf((SSQ[t] + SSQ[64 + t]) * (1.f / 128.f) + EPS);
          const bf16* grow = PROJ + (size_t)(row0 + t) * NINP + PC_G + h * 128;
          bf16* orow = MIX + (size_t)(row0 + t) * DM + h * 128;
#pragma unroll
          for (int i4 = 0; i4 < 4; ++i4) {
              const int e = (eh * 4 + i4) * 16 + 4 * fq;
              const v2u gr = *(const v2u*)(grow + e); const f32x4 gn = *(const f32x4*)(gla_norm + h * 128 + e);
              const float y0 = o[i4][0] * rstd * gn[0] * silu_f(bflo(gr.x)), y1 = o[i4][1] * rstd * gn[1] * silu_f(bfhi(gr.x));
              const float y2 = o[i4][2] * rstd * gn[2] * silu_f(bflo(gr.y)), y3 = o[i4][3] * rstd * gn[3] * silu_f(bfhi(gr.y));
              *(v2u*)(orow + e) = (v2u){pk2(y0, y1), pk2(y2, y3)};
          } }
        __syncthreads();
    }
}

#define XB_TMO      128
#define XB_XCNT(j)  (256  + 64 * (j))
#define XB_XSUB(j)  (1280 + 64 * (j))
#define XB_XGEN(j)  (2304 + 64 * (j))
#define XB_TOP      3328
#define XB_TOPGEN   3392
#define XCD_BAR_WORDS 3456
#define XB_SPIN_CAP (1u << 18)

__device__ __forceinline__ unsigned xb_ld(unsigned* p)              { return __hip_atomic_load(p, __ATOMIC_RELAXED, __HIP_MEMORY_SCOPE_AGENT); }
__device__ __forceinline__ unsigned xb_add(unsigned* p, unsigned v) { return __hip_atomic_fetch_add(p, v, __ATOMIC_RELAXED, __HIP_MEMORY_SCOPE_AGENT); }
__device__ __forceinline__ unsigned xb_xcc_id() { return (unsigned)__builtin_amdgcn_s_getreg((3 << 11) | 20) & 0xFu; }
#define XB_SPIN(cond, bar) do { unsigned _sp = 0; while (cond) { __builtin_amdgcn_s_sleep(1); \
    if ((++_sp & 255u) == 0u) { if (xb_ld(&(bar)[XB_TMO])) break; if (_sp > XB_SPIN_CAP) { atomicAdd(&(bar)[XB_TMO], 1u); break; } } } } while (0)

struct XcdBarrier {
    unsigned* bar; unsigned x;
    volatile LAS unsigned* st;
};

__device__ __forceinline__ XcdBarrier xcd_barrier_post(unsigned* bar, volatile LAS unsigned* st) {
    XcdBarrier b; b.bar = bar; b.x = xb_xcc_id(); b.st = st;
    if (threadIdx.x == 0) (void)xb_add(&bar[XB_XCNT(b.x)], 1u);
    return b;
}
__device__ __forceinline__ void xcd_barrier_complete(unsigned* bar, unsigned x, unsigned& nloc, unsigned& nx) {
    const unsigned G = gridDim.x * gridDim.y * gridDim.z;
    unsigned sum, cnt, mine, sp = 0u;
    for (;;) {
        sum = 0u; cnt = 0u; mine = 0u;
#pragma unroll
        for (unsigned j = 0; j < 16; ++j) { const unsigned c = xb_ld(&bar[XB_XCNT(j)]); sum += c; cnt += (c > 0u) ? 1u : 0u; mine = (j == x) ? c : mine; }
        if (sum == G) break;
        __builtin_amdgcn_s_sleep(1);
        if ((++sp & 255u) == 0u) { if (xb_ld(&bar[XB_TMO])) break; if (sp > XB_SPIN_CAP) { atomicAdd(&bar[XB_TMO], 1u); break; } }
    }
    nloc = mine > 0u ? mine : 1u; nx = cnt > 0u ? cnt : 1u;
}

__device__ __forceinline__ void xcd_barrier(const XcdBarrier& b) {
    asm volatile("s_waitcnt vmcnt(0)" ::: "memory");
    __syncthreads();
    if (threadIdx.x == 0) {
        unsigned* bar = b.bar;
        __builtin_amdgcn_s_waitcnt(0);
        unsigned nloc = b.st[0], nx = b.st[1];
        if (nloc == 0u) { xcd_barrier_complete(bar, b.x, nloc, nx); b.st[0] = nloc; b.st[1] = nx; }
        const unsigned old = xb_add(&bar[XB_XSUB(b.x)], 1u);
        const unsigned gen = old / nloc;
        if (old + 1u == (gen + 1u) * nloc) {
            __builtin_amdgcn_fence(__ATOMIC_RELEASE, "agent");
            asm volatile("s_waitcnt vmcnt(0)" ::: "memory");
            const unsigned og = xb_add(&bar[XB_TOP], 1u);
            const unsigned tg = og / nx;
            if (og + 1u == (tg + 1u) * nx) xb_add(&bar[XB_TOPGEN], 1u);
            else XB_SPIN(xb_ld(&bar[XB_TOPGEN]) == tg, bar);
            __builtin_amdgcn_fence(__ATOMIC_ACQUIRE, "agent");
            xb_add(&bar[XB_XGEN(b.x)], 1u);
            asm volatile("s_waitcnt vmcnt(0)" ::: "memory");
        } else {
            XB_SPIN(xb_ld(&bar[XB_XGEN(b.x)]) == gen, bar);
            __builtin_amdgcn_fence(__ATOMIC_ACQUIRE, "agent");
            asm volatile("s_waitcnt vmcnt(0)" ::: "memory");
        }
    }
    __syncthreads();
}
struct Args {
    const float *x_prompt, *x_sample, *state_gla, *c, *c_ctx, *w_ada, *b_ada, *norm_ffn1, *w1_ffn1, *w3_ffn1, *w2_ffn1, *norm_mix, *w_in, *w_decay, *b_decay,
                *gla_norm, *conv_w, *w_out, *norm_ffn2, *w1_ffn2, *w3_ffn2, *w2_ffn2, *final_norm;
    float* out; unsigned char* ws;
};

enum { I_XP = 0, I_XS, I_STATE, I_C, I_CCTX, I_WADA, I_BADA, I_NF1, I_W1A, I_W3A, I_W2A, I_NMIX, I_WIN, I_WDEC, I_BDEC, I_GNORM, I_CONVW, I_WOUT, I_NF2, I_W1B, I_W3B, I_W2B, I_FNORM, I_OUT, I_WS };
constexpr int LDS_XST = 140000, LDS_ARGS = 140032;
__device__ __forceinline__ unsigned long long ldarg(LAS unsigned char* L, int i) {
    const unsigned long long v = *(volatile LAS unsigned long long*)(L + LDS_ARGS + 8 * i);
    const unsigned lo = __builtin_amdgcn_readfirstlane((unsigned)v), hi = __builtin_amdgcn_readfirstlane((unsigned)(v >> 32));
    return ((unsigned long long)hi << 32) | lo;
}
#define ARGF(i) ((const float*)ldarg(L, (i)))
#define WSP() ((unsigned char*)ldarg(L, I_WS))
#define OUTP() ((float*)ldarg(L, I_OUT))
#undef GSYNC
#define GSYNC() do { for (int r_ = 0; r_ < REP_SYNC; ++r_) { XcdBarrier xb_; xb_.bar = (unsigned*)(WSP() + WS_BAR); xb_.x = xb_xcc_id(); xb_.st = (volatile LAS unsigned*)(L + LDS_XST); xcd_barrier(xb_); } } while (0)

__global__ void __launch_bounds__(512, 2) mega_fwd(Args A) {
    extern __shared__ __attribute__((aligned(16))) unsigned char lds_raw[];
    LAS unsigned char* L = (LAS unsigned char*)lds_raw;
    const int tid = threadIdx.x, lane = tid & 63, wave = __builtin_amdgcn_readfirstlane(tid >> 6);
    if (A.ws == nullptr) { cg::grid_group grid = cg::this_grid(); grid.sync(); }
    if (tid == 0) {
        LAS unsigned long long* LA = (LAS unsigned long long*)(L + LDS_ARGS);
        LA[I_XP] = (unsigned long long)A.x_prompt; LA[I_XS] = (unsigned long long)A.x_sample; LA[I_STATE] = (unsigned long long)A.state_gla; LA[I_C] = (unsigned long long)A.c;
        LA[I_CCTX] = (unsigned long long)A.c_ctx; LA[I_WADA] = (unsigned long long)A.w_ada; LA[I_BADA] = (unsigned long long)A.b_ada; LA[I_NF1] = (unsigned long long)A.norm_ffn1;
        LA[I_W1A] = (unsigned long long)A.w1_ffn1; LA[I_W3A] = (unsigned long long)A.w3_ffn1; LA[I_W2A] = (unsigned long long)A.w2_ffn1; LA[I_NMIX] = (unsigned long long)A.norm_mix;
        LA[I_WIN] = (unsigned long long)A.w_in; LA[I_WDEC] = (unsigned long long)A.w_decay; LA[I_BDEC] = (unsigned long long)A.b_decay; LA[I_GNORM] = (unsigned long long)A.gla_norm;
        LA[I_CONVW] = (unsigned long long)A.conv_w; LA[I_WOUT] = (unsigned long long)A.w_out; LA[I_NF2] = (unsigned long long)A.norm_ffn2; LA[I_W1B] = (unsigned long long)A.w1_ffn2;
        LA[I_W3B] = (unsigned long long)A.w3_ffn2; LA[I_W2B] = (unsigned long long)A.w2_ffn2; LA[I_FNORM] = (unsigned long long)A.final_norm; LA[I_OUT] = (unsigned long long)A.out;
        LA[I_WS] = (unsigned long long)A.ws;
    }
    if (tid < 2) ((volatile LAS unsigned*)(L + LDS_XST))[tid] = 0u;
    __syncthreads();
    (void)xcd_barrier_post((unsigned*)(WSP() + WS_BAR), (volatile LAS unsigned*)(L + LDS_XST));
#define GW (blockIdx.x * 8 + wave)
#define NGW_ (gridDim.x * 8)
#define GTID (blockIdx.x * 512 + tid)
#define NTHR (gridDim.x * 512)
#define P_MODS ((float*)(WSP() + WS_MODS))
#define P_H ((bf16*)(WSP() + WS_H))
#define P_PROJ ((bf16*)(WSP() + WS_PROJ))
#define P_STATE ((float*)(WSP() + WS_STATE))
#define P_TOT ((float*)(WSP() + WS_TOT))

    for (int r_ = 0; r_ < REP_P0; ++r_) {
    phase_mods(L, ARGF(I_C), ARGF(I_CCTX), ARGF(I_WADA), ARGF(I_BADA), P_MODS, tid);
    { WPtrs W{ARGF(I_W1A), ARGF(I_W3A), ARGF(I_W2A), ARGF(I_WIN), ARGF(I_WOUT), ARGF(I_W1B), ARGF(I_W3B), ARGF(I_W2B)};
      phase_weights(L, W, WSP(), GW, NGW_, wave, lane, GTID, NTHR); }
    __syncthreads(); }
    GSYNC();
    for (int r_ = 0; r_ < REP_NORM; ++r_) phase_normmod(ARGF(I_XP), ARGF(I_XS), ARGF(I_NF1), P_MODS, 0, 1, P_H, GW, NGW_, lane);
    GSYNC();
    { unsigned char* ws = WSP(); pg8::Gemm g{(const bf16*)(ws + WS_H), (const bf16*)(ws + WS_WUP1), NTOK, 2 * DFF, DM}; pg8::StaticOrder S; S.init(NTOK, 2 * DFF, gridDim.x, (int)blockIdx.x);
      EpiSwiglu E{(bf16*)(ws + WS_PROJ), DFF}; pg8::gemm_phase<EpiSwiglu, pg8::StaticOrder, true, true>(L, g, S, E); }
    GSYNC();
    { unsigned char* ws = WSP(); pg8::Gemm g{(const bf16*)(ws + WS_PROJ), (const bf16*)(ws + WS_WDN1), NTOK, DM, DFF}; pg8::StaticOrder S; S.init(NTOK, DM, gridDim.x, (int)blockIdx.x);
      EpiResid E{ARGF(I_XP), ARGF(I_XS), OUTP(), (const float*)(ws + WS_MODS), 2, 0.5f}; pg8::gemm_phase<EpiResid, pg8::StaticOrder, true, true>(L, g, S, E); }
    GSYNC();
    { float* RES = OUTP(); phase_normmod(RES, RES + (size_t)NP * DM, ARGF(I_NMIX), P_MODS, 3, 4, P_H, GW, NGW_, lane); }
    GSYNC();
    { unsigned char* ws = WSP(); pg8::Gemm g{(const bf16*)(ws + WS_H), (const bf16*)(ws + WS_WIN), NTOK, NINP, DM}; pg8::StaticOrder S; S.init(NTOK, NINP, gridDim.x, (int)blockIdx.x);
      pg8::EpiBf16<0> E{(bf16*)(ws + WS_PROJ), NINP, nullptr, 0, 0, 1.f}; pg8::gemm_phase<pg8::EpiBf16<0>, pg8::StaticOrder, true, true>(L, g, S, E); }
    GSYNC();
    for (int r_ = 0; r_ < REP_GLA; ++r_) phase_gla_local(L, P_PROJ, ARGF(I_WDEC), ARGF(I_BDEC), P_STATE, P_TOT, tid);
    GSYNC();
    phase_scan(P_STATE, P_TOT, ARGF(I_STATE), OUTP() + (size_t)NTOK * DM, GTID, NTHR);
    GSYNC();
    for (int r_ = 0; r_ < REP_GLA; ++r_) phase_gla_out(L, P_PROJ, ARGF(I_WDEC), ARGF(I_BDEC), P_STATE, ARGF(I_GNORM), ARGF(I_CONVW), P_H, tid);
    GSYNC();
    { unsigned char* ws = WSP(); float* RES = OUTP(); pg8::Gemm g{(const bf16*)(ws + WS_H), (const bf16*)(ws + WS_WOUT), NTOK, DM, DM}; pg8::StaticOrder S; S.init(NTOK, DM, gridDim.x, (int)blockIdx.x);
      EpiResid E{RES, RES + (size_t)NP * DM, RES, (const float*)(ws + WS_MODS), 5, 1.0f}; pg8::gemm_phase<EpiResid, pg8::StaticOrder, true, true>(L, g, S, E); }
    GSYNC();
    { float* RES = OUTP(); phase_normmod(RES, RES + (size_t)NP * DM, ARGF(I_NF2), P_MODS, 6, 7, P_H, GW, NGW_, lane); }
    GSYNC();
    { unsigned char* ws = WSP(); pg8::Gemm g{(const bf16*)(ws + WS_H), (const bf16*)(ws + WS_WUP2), NTOK, 2 * DFF, DM}; pg8::StaticOrder S; S.init(NTOK, 2 * DFF, gridDim.x, (int)blockIdx.x);
      EpiSwiglu E{(bf16*)(ws + WS_PROJ), DFF}; pg8::gemm_phase<EpiSwiglu, pg8::StaticOrder, true, true>(L, g, S, E); }
    GSYNC();
    { unsigned char* ws = WSP(); float* RES = OUTP(); pg8::Gemm g{(const bf16*)(ws + WS_PROJ), (const bf16*)(ws + WS_WDN2), NTOK, DM, DFF}; pg8::StaticOrder S; S.init(NTOK, DM, gridDim.x, (int)blockIdx.x);
      EpiResid E{RES, RES + (size_t)NP * DM, RES, (const float*)(ws + WS_MODS), 8, 0.5f}; pg8::gemm_phase<EpiResid, pg8::StaticOrder, true, true>(L, g, S, E); }
    GSYNC();
    phase_final_norm(OUTP(), ARGF(I_FNORM), GW, NGW_, lane);
}

extern "C" void kernel_launch(void* const* d_in, const int* in_sizes, int n_in, void* d_out, int out_size, void* d_ws, size_t ws_size, hipStream_t stream) {
    static int grid = 0;
    if (grid == 0) {
        if (n_in != 23 || ws_size < WS_END) { fprintf(stderr, "kernel_launch: unexpected n_in %d / ws %zu\n", n_in, ws_size); grid = -1; return; }
        int dev = 0, cus = 0, per_cu = 0;
        hipGetDevice(&dev);
        hipDeviceGetAttribute(&cus, hipDeviceAttributeMultiprocessorCount, dev);
        if (hipFuncSetAttribute((const void*)mega_fwd, hipFuncAttributeMaxDynamicSharedMemorySize, LDS_BYTES) != hipSuccess) { fprintf(stderr, "kernel_launch: hipFuncSetAttribute failed\n"); grid = -1; return; }
        hipOccupancyMaxActiveBlocksPerMultiprocessor(&per_cu, (const void*)mega_fwd, 512, LDS_BYTES);
        if (per_cu < 1) per_cu = 1;
        (void)hipGetLastError();
        grid = cus;
        if (grid > 256) grid = 256;
    }
    if (grid < 0) return;
    Args a{};
    const float** p = (const float**)&a;
    for (int i = 0; i < 23; ++i) p[i] = (const float*)d_in[i];
    a.out = (float*)d_out; a.ws = (unsigned char*)d_ws;
    (void)hipMemsetAsync((char*)d_ws + WS_BAR, 0, XCD_BAR_WORDS * 4, stream);
    void* args[] = {&a};
    hipError_t e = hipLaunchCooperativeKernel((const void*)mega_fwd, dim3(grid), dim3(512), args, LDS_BYTES, stream);
    if (e != hipSuccess) fprintf(stderr, "cooperative launch failed: %s (grid %d)\n", hipGetErrorString(e), grid);
}
```

```cpp
#include <hip/hip_runtime.h>
#include <hip/hip_cooperative_groups.h>
#include <cstdio>
#include <cstdint>
namespace cg = cooperative_groups;
namespace pg8 {
#define PG8_LAS __attribute__((address_space(3)))
typedef unsigned short bf16_t;
typedef short bf16x8 __attribute__((ext_vector_type(8)));
typedef float f32x4 __attribute__((ext_vector_type(4)));
typedef unsigned u32x4 __attribute__((ext_vector_type(4)));
constexpr int BM = 256, BK = 64, HALF = 128, HTB = HALF * BK * 2  , STAGE_BYTES = 8 * HTB, NXCD = 8, WGM = 8;

__host__ __device__ __forceinline__ int lds_byte(int r, int c) { const int st = (r >> 4) * 2 + (c >> 5), rr = r & 15, cc = c & 31, ob = rr * 64 + cc * 2; return st * 1024 + (ob ^ (((ob >> 9) & 1) << 5)); }
__host__ __device__ __forceinline__ void stage_rc(int b, int& R, int& C) { const int st = b / 1024, sb = b % 1024, swz = sb ^ (((sb >> 9) & 1) << 5); R = (st >> 1) * 16 + swz / 64; C = (st & 1) * 32 + (swz % 64) / 2; }
__host__ __device__ __forceinline__ int perm32(int rho) { const int n = rho >> 4, i = rho & 15; return 8 * (i >> 2) + 4 * n + (i & 3); }

struct Unit { int pm, pn; };
struct Gemm { const bf16_t* A; const bf16_t* Bt; int M, N, K; };

struct StaticOrder {
    int nM, nN, nwg, G, c;
    __host__ __device__ void init(int M, int N, int G_, int c_) { nM = M / BM; nN = N / BM; nwg = nM * nN; G = G_; c = c_; }
    __host__ __device__ bool next(int i, Unit& u) const {
        const long L = (long)i * G + c; if (L >= nwg) return false;
        int wgid = (int)L; { const int q = nwg / NXCD, r = nwg % NXCD, xcd = wgid % NXCD, off = wgid / NXCD; wgid = (xcd < r ? xcd * (q + 1) : r * (q + 1) + (xcd - r) * q) + off; }
        const int nig = WGM * nN, gid = wgid / nig, fm = gid * WGM, gsz = (nM - fm) < WGM ? (nM - fm) : WGM;
        u.pm = fm + ((wgid % nig) % gsz); u.pn = (wgid % nig) / gsz; return true;
    }
    __device__ __forceinline__ void a_ready(const Unit&) const {}
    __device__ __forceinline__ void done(const Unit&) const {}
};

__device__ __forceinline__ unsigned cvt_pk_bf16(float lo, float hi) { unsigned r; asm volatile("v_cvt_pk_bf16_f32 %0, %1, %2" : "=v"(r) : "v"(lo), "v"(hi)); return r; }
typedef float f32x2 __attribute__((ext_vector_type(2)));
__device__ __forceinline__ f32x2 gelu_pk(f32x2 v) {
    const f32x2 av = __builtin_elementwise_abs(v), d = av * 0.2316418882f + 1.0f;
    f32x2 t; t.x = __builtin_amdgcn_rcpf(d.x); t.y = __builtin_amdgcn_rcpf(d.y);
    f32x2 q = t * 0.5307027145f + (-0.7265760135f); q = q * t + 0.7107068705f; q = q * t + (-0.142248368f); q = q * t + 0.127414796f; q = q * t;
    const f32x2 s = (v * v) * (-0.72134752044f);
    f32x2 e; e.x = __builtin_amdgcn_exp2f(s.x); e.y = __builtin_amdgcn_exp2f(s.y);
    const f32x2 m = v * (q * e), r = v - m;
    f32x2 o; o.x = v.x < 0.f ? m.x : r.x; o.y = v.y < 0.f ? m.y : r.y; return o;
}

template <int ACT  > struct EpiBf16 {
    static constexpr bool PERM = true, AFTER_DRAIN = false; static_assert(ACT == 0 || ACT == 1, "EpiBf16: ACT is 0 (none) or 1 (gelu_pk)");
    bf16_t* O; int ldc; const float* bias; int split_cols; size_t split_stride; float scale0;
    __device__ __forceinline__ void operator()(const f32x4 (&acc)[2][2][4][2], const Unit& u, int wr, int wc, int fr, int fq) const {
        const int row0 = u.pm * BM + wr * 64 + fr; int colt = u.pn * BM; bf16_t* base = O;
        float sc = 1.f; if (split_cols) { const int t = colt / split_cols; base += (size_t)t * split_stride; colt -= t * split_cols; if (t == 0) sc = scale0; }
        const int col0 = colt + wc * 32 + 8 * fq, bcol0 = u.pn * BM + wc * 32 + 8 * fq;
        f32x4 bv[2][2];
#pragma unroll
        for (int bj = 0; bj < 2; ++bj)
#pragma unroll
            for (int n = 0; n < 2; ++n) bv[bj][n] = bias ? *(const f32x4*)(bias + bcol0 + bj * HALF + 4 * n) : (f32x4){0.f, 0.f, 0.f, 0.f};
#pragma unroll
        for (int ai = 0; ai < 2; ++ai)
#pragma unroll
            for (int m = 0; m < 4; ++m) { bf16_t* rowp = base + (size_t)(row0 + ai * HALF + m * 16) * ldc + col0;
#pragma unroll
                for (int bj = 0; bj < 2; ++bj) { f32x4 v0 = acc[ai][bj][m][0] + bv[bj][0], v1 = acc[ai][bj][m][1] + bv[bj][1];
                    if (ACT == 1) { f32x2 a = gelu_pk((f32x2){v0[0], v0[1]}), b = gelu_pk((f32x2){v0[2], v0[3]}), c = gelu_pk((f32x2){v1[0], v1[1]}), d = gelu_pk((f32x2){v1[2], v1[3]});
                        v0 = (f32x4){a.x, a.y, b.x, b.y}; v1 = (f32x4){c.x, c.y, d.x, d.y}; }
                    v0 = v0 * sc; v1 = v1 * sc; u32x4 w; w.x = cvt_pk_bf16(v0[0], v0[1]); w.y = cvt_pk_bf16(v0[2], v0[3]); w.z = cvt_pk_bf16(v1[0], v1[1]); w.w = cvt_pk_bf16(v1[2], v1[3]);
                    *(u32x4*)(rowp + bj * HALF) = w; } }
    }
};

template <class Epi, class Sched, bool ALIGN_EPI = false, bool SP2 = false>
__device__ __forceinline__ void gemm_phase(PG8_LAS unsigned char* lds, const Gemm g, const Sched& S, const Epi& E) {
    const int tid = threadIdx.x, wid = __builtin_amdgcn_readfirstlane(tid >> 6), lane = tid & 63, wr = wid >> 2, wc = wid & 3, fr = lane & 15, fq = lane >> 4;
    const int K = g.K, nt = K / BK;
    unsigned voffA[2], voffB[2];
#pragma unroll
    for (int i = 0; i < 2; ++i) { int R, C; stage_rc(tid * 16 + i * 8192, R, C); const int Rb = Epi::PERM ? ((R & ~31) + perm32(R & 31)) : R;
        voffA[i] = (unsigned)(R * K + C) * 2u; voffB[i] = (unsigned)(Rb * K + C) * 2u; }
    const size_t kstep = (size_t)(BK * 2);
    const size_t hstep = (size_t)HALF * K * 2;
    const size_t tstep = 2 * hstep;
    const unsigned ldsw = (unsigned)wid * 1024u;
    const int aoff = lds_byte(wr * 64 + fr, fq * 8), boff = lds_byte(wc * 32 + fr, fq * 8);
#define PG8_SA(b, h) (((b) * 2 + (h)) * HTB)
#define PG8_SB(b, h) ((4 + (b) * 2 + (h)) * HTB)
#define PG8_STAGE(bufoff, gbase, voff) do { _Pragma("unroll") for (int _i = 0; _i < 2; ++_i) \
        __builtin_amdgcn_global_load_lds((const unsigned*)((const char*)(gbase) + (voff)[_i]), (PG8_LAS unsigned*)(lds + (bufoff) + ldsw + _i * 8192), 16, 0, 0); } while (0)
#define PG8_LDA(dst, b, h) do { _Pragma("unroll") for (int m = 0; m < 4; ++m) _Pragma("unroll") for (int k = 0; k < 2; ++k) dst[m][k] = *(const PG8_LAS bf16x8*)(lds + PG8_SA(b, h) + aoff + m * 2048 + k * 1024); } while (0)
#define PG8_LDB(dst, b, h) do { _Pragma("unroll") for (int n = 0; n < 2; ++n) _Pragma("unroll") for (int k = 0; k < 2; ++k) dst[n][k] = *(const PG8_LAS bf16x8*)(lds + PG8_SB(b, h) + boff + n * 2048 + k * 1024); } while (0)
#define PG8_MMA(ai, bj, At, Bt) do { __builtin_amdgcn_s_setprio(1); _Pragma("unroll") for (int m = 0; m < 4; ++m) _Pragma("unroll") for (int n = 0; n < 2; ++n) _Pragma("unroll") for (int k = 0; k < 2; ++k) \
        acc[ai][bj][m][n] = __builtin_amdgcn_mfma_f32_16x16x32_bf16(Bt[n][k], At[m][k], acc[ai][bj][m][n], 0, 0, 0); __builtin_amdgcn_s_setprio(0); } while (0)
#define PG8_WAIT_V(n) asm volatile("s_waitcnt vmcnt(" #n ")" ::: "memory")
#define PG8_WAIT_L(n) asm volatile("s_waitcnt lgkmcnt(" #n ")" ::: "memory")
#define PG8_BAR __builtin_amdgcn_s_barrier()
#define PG8_SCHED __builtin_amdgcn_sched_barrier(0)
    Unit cur, nxt; int ui = 0;
    if (!S.next(0, cur)) return;
    f32x4 acc[2][2][4][2];
#pragma unroll
    for (int a = 0; a < 2; ++a)
#pragma unroll
        for (int b = 0; b < 2; ++b)
#pragma unroll
            for (int m = 0; m < 4; ++m)
#pragma unroll
                for (int n = 0; n < 2; ++n) acc[a][b][m][n] = (f32x4){0.f, 0.f, 0.f, 0.f};
    bf16x8 At[4][2], B0[2][2], B1[2][2];
    const char* cA = (const char*)g.A + (size_t)cur.pm * tstep; const char* cB = (const char*)g.Bt + (size_t)cur.pn * tstep;
    S.a_ready(cur);
    if constexpr (SP2) {
        PG8_STAGE(PG8_SB(0, 0), cB, voffB); PG8_STAGE(PG8_SB(0, 1), cB + hstep, voffB); PG8_STAGE(PG8_SA(0, 0), cA, voffA); PG8_STAGE(PG8_SA(0, 1), cA + hstep, voffA);
        if (wr == 1) PG8_BAR;
        PG8_WAIT_V(2); PG8_BAR;
        PG8_STAGE(PG8_SB(1, 0), cB + kstep, voffB); PG8_STAGE(PG8_SA(1, 0), cA + kstep, voffA); PG8_STAGE(PG8_SB(1, 1), cB + hstep + kstep, voffB);
        PG8_WAIT_V(6); PG8_BAR;
    } else {
        PG8_STAGE(PG8_SB(0, 0), cB, voffB); PG8_STAGE(PG8_SA(0, 0), cA, voffA); PG8_STAGE(PG8_SB(0, 1), cB + hstep, voffB); PG8_STAGE(PG8_SA(0, 1), cA + hstep, voffA);
        if (wr == 1) PG8_BAR;
        PG8_WAIT_V(4); PG8_BAR;
        PG8_STAGE(PG8_SB(1, 0), cB + kstep, voffB); PG8_STAGE(PG8_SA(1, 0), cA + kstep, voffA); PG8_STAGE(PG8_SB(1, 1), cB + hstep + kstep, voffB);
        PG8_WAIT_V(6); PG8_BAR;
    }
    for (;;) {
        const bool has_next = S.next(ui + 1, nxt);
        const char* nA = has_next ? (const char*)g.A + (size_t)nxt.pm * tstep : cA; const char* nB = has_next ? (const char*)g.Bt + (size_t)nxt.pn * tstep : cB;
        for (int t = 0; t < nt; t += 2) {
            const bool last = (t == nt - 2);
            const char* a1 = cA + (size_t)(t + 1) * kstep;
            const char* a2 = last ? nA : cA + (size_t)(t + 2) * kstep; const char* b2 = last ? nB : cB + (size_t)(t + 2) * kstep;
            const char* a3 = a2 + kstep; const char* b3 = b2 + kstep;
            if (last && has_next) S.a_ready(nxt);
            if constexpr (SP2) {
            PG8_LDB(B0, 0, 0); PG8_LDB(B1, 0, 1); PG8_SCHED; PG8_LDA(At, 0, 0); PG8_STAGE(PG8_SA(1, 1), a1 + hstep, voffA);
            PG8_WAIT_V(8); PG8_WAIT_L(0); PG8_BAR; PG8_MMA(0, 0, At, B0); PG8_MMA(0, 1, At, B1); PG8_BAR; PG8_SCHED;
            PG8_LDA(At, 0, 1); PG8_STAGE(PG8_SB(0, 0), b2, voffB); PG8_STAGE(PG8_SB(0, 1), b2 + hstep, voffB); PG8_STAGE(PG8_SA(0, 0), a2, voffA);
            PG8_WAIT_V(8); PG8_WAIT_L(0); PG8_BAR; PG8_MMA(1, 0, At, B0); PG8_MMA(1, 1, At, B1); PG8_BAR; PG8_SCHED;
            PG8_LDB(B0, 1, 0); PG8_LDB(B1, 1, 1); PG8_SCHED; PG8_LDA(At, 1, 0); PG8_STAGE(PG8_SA(0, 1), a2 + hstep, voffA);
            PG8_WAIT_V(8); PG8_WAIT_L(0); PG8_BAR; PG8_MMA(0, 0, At, B0); PG8_MMA(0, 1, At, B1); PG8_BAR; PG8_SCHED;
            PG8_LDA(At, 1, 1); PG8_STAGE(PG8_SB(1, 0), b3, voffB); PG8_STAGE(PG8_SB(1, 1), b3 + hstep, voffB); PG8_STAGE(PG8_SA(1, 0), a3, voffA);
            PG8_WAIT_V(8); PG8_WAIT_L(0); PG8_BAR; PG8_MMA(1, 0, At, B0); PG8_MMA(1, 1, At, B1); PG8_BAR; PG8_SCHED;
            } else {
            PG8_LDB(B0, 0, 0); PG8_SCHED; PG8_LDA(At, 0, 0); PG8_STAGE(PG8_SA(1, 1), a1 + hstep, voffA);
            PG8_WAIT_L(8); PG8_BAR; PG8_WAIT_L(0); PG8_MMA(0, 0, At, B0); PG8_BAR; PG8_SCHED;
            PG8_LDB(B1, 0, 1); PG8_STAGE(PG8_SB(0, 0), b2, voffB);
            PG8_BAR; PG8_WAIT_L(0); PG8_MMA(0, 1, At, B1); PG8_BAR;
            PG8_LDA(At, 0, 1); PG8_STAGE(PG8_SA(0, 0), a2, voffA);
            PG8_BAR; PG8_WAIT_L(0); PG8_MMA(1, 0, At, B0); PG8_BAR; PG8_SCHED;
            PG8_STAGE(PG8_SB(0, 1), b2 + hstep, voffB);
            PG8_WAIT_V(6); PG8_BAR; PG8_MMA(1, 1, At, B1); PG8_BAR;
            PG8_LDB(B0, 1, 0); PG8_SCHED; PG8_LDA(At, 1, 0); PG8_STAGE(PG8_SA(0, 1), a2 + hstep, voffA);
            PG8_WAIT_L(8); PG8_BAR; PG8_WAIT_L(0); PG8_MMA(0, 0, At, B0); PG8_BAR; PG8_SCHED;
            PG8_LDB(B1, 1, 1); PG8_STAGE(PG8_SB(1, 0), b3, voffB);
            PG8_BAR; PG8_WAIT_L(0); PG8_MMA(0, 1, At, B1); PG8_BAR;
            PG8_LDA(At, 1, 1); PG8_STAGE(PG8_SA(1, 0), a3, voffA);
            PG8_BAR; PG8_WAIT_L(0); PG8_MMA(1, 0, At, B0); PG8_BAR; PG8_SCHED;
            PG8_STAGE(PG8_SB(1, 1), b3 + hstep, voffB);
            PG8_WAIT_V(6); PG8_BAR; PG8_MMA(1, 1, At, B1); PG8_BAR;
            }
        }
        if constexpr (ALIGN_EPI) { if (wr == 0) PG8_BAR; }
        if constexpr (!Epi::AFTER_DRAIN) { E(acc, cur, wr, wc, fr, fq); S.done(cur); }
        if (!has_next) break;
#pragma unroll
        for (int a = 0; a < 2; ++a)
#pragma unroll
            for (int b = 0; b < 2; ++b)
#pragma unroll
                for (int m = 0; m < 4; ++m)
#pragma unroll
                    for (int n = 0; n < 2; ++n) acc[a][b][m][n] = (f32x4){0.f, 0.f, 0.f, 0.f};
        cur = nxt; cA = nA; cB = nB; ++ui;
        if constexpr (ALIGN_EPI) { if (wr == 1) PG8_BAR; }
    }
    PG8_WAIT_V(0);
    if constexpr (!ALIGN_EPI) { if (wr == 0) PG8_BAR; }
    PG8_BAR;
    if constexpr (Epi::AFTER_DRAIN) { E.fused(acc, cur, wr, wc, fr, fq, lds, wid, lane); S.done(cur); }
#undef PG8_SA
#undef PG8_SB
#undef PG8_STAGE
#undef PG8_LDA
#undef PG8_LDB
#undef PG8_MMA
#undef PG8_WAIT_V
#undef PG8_WAIT_L
#undef PG8_BAR
#undef PG8_SCHED
}
}

#define GAS __attribute__((address_space(1)))
#define LAS __attribute__((address_space(3)))
typedef unsigned short bf16;
typedef unsigned v4u __attribute__((ext_vector_type(4)));
typedef unsigned v2u __attribute__((ext_vector_type(2)));
typedef float f32x4 __attribute__((ext_vector_type(4)));
typedef short bf16x8 __attribute__((ext_vector_type(8)));

constexpr int NTOK = 16384, NP = 8192, DM = 1024, DFF = 2816, NIN = 3104, NINP = 3328;
constexpr int NMOD = 9, NMODROW = 5;
constexpr float EPS = 1e-6f;
constexpr int PC_Q = 0, PC_K = 256, PC_V = 512, PC_G = 1024, PC_LR = 1536, PC_CB = 1568, PC_CC = 2080, PC_CH = 2592;

constexpr size_t MiB = 1u << 20;
constexpr size_t WS_MODS = 0;
constexpr size_t WS_BAR = 512 * 1024;
constexpr size_t WS_WUP1 = 1 * MiB, WS_WDN1 = 12 * MiB, WS_WIN = 18 * MiB, WS_WOUT = 25 * MiB, WS_WUP2 = 27 * MiB, WS_WDN2 = 38 * MiB;
constexpr size_t WS_H = 44 * MiB;
constexpr size_t WS_PROJ = 76 * MiB;
constexpr size_t WS_STATE = 180 * MiB;
constexpr size_t WS_TOT = 244 * MiB;
constexpr size_t WS_END = 245 * MiB;
constexpr int LDS_BYTES = 147456;
#ifndef REP_SYNC
#define REP_SYNC 1
#endif
#ifndef REP_P0
#define REP_P0 1
#endif
#ifndef REP_GLA
#define REP_GLA 1
#endif
#ifndef REP_NORM
#define REP_NORM 1
#endif
#define GSYNC() do { for (int r_ = 0; r_ < REP_SYNC; ++r_) { XcdBarrier xb_; xb_.bar = (unsigned*)(A.ws + WS_BAR); xb_.x = xb_xcc_id(); xb_.st = (volatile LAS unsigned*)(L + 140000); xcd_barrier(xb_); } } while (0)

__device__ __forceinline__ float bf2f(unsigned b) { return __uint_as_float(b << 16); }
__device__ __forceinline__ float bflo(unsigned w) { return __uint_as_float(w << 16); }
__device__ __forceinline__ float bfhi(unsigned w) { return __uint_as_float(w & 0xffff0000u); }
__device__ __forceinline__ unsigned pk2(float lo, float hi) { return pg8::cvt_pk_bf16(lo, hi); }
__device__ __forceinline__ float wave_sum(float v) {
#pragma unroll
    for (int o = 1; o < 64; o <<= 1) v += __shfl_xor(v, o);
    return v;
}
__device__ __forceinline__ float silu_f(float g) { return g * __builtin_amdgcn_rcpf(1.f + __expf(-g)); }

struct EpiSwiglu {
    static constexpr bool PERM = true, AFTER_DRAIN = false;
    bf16* O; int ldc;
    __device__ __forceinline__ void operator()(const pg8::f32x4 (&acc)[2][2][4][2], const pg8::Unit& u, int wr, int wc, int fr, int fq) const {
        const int row0 = u.pm * 256 + wr * 64 + fr, col0 = u.pn * 128 + wc * 32 + 8 * fq;
#pragma unroll
        for (int ai = 0; ai < 2; ++ai)
#pragma unroll
            for (int m = 0; m < 4; ++m) {
                bf16* rowp = O + (size_t)(row0 + ai * 128 + m * 16) * ldc + col0;
                const pg8::f32x4 g0 = acc[ai][0][m][0], g1 = acc[ai][0][m][1], u0 = acc[ai][1][m][0], u1 = acc[ai][1][m][1];
                v4u w;
                w.x = pk2(silu_f(g0[0]) * u0[0], silu_f(g0[1]) * u0[1]);
                w.y = pk2(silu_f(g0[2]) * u0[2], silu_f(g0[3]) * u0[3]);
                w.z = pk2(silu_f(g1[0]) * u1[0], silu_f(g1[1]) * u1[1]);
                w.w = pk2(silu_f(g1[2]) * u1[2], silu_f(g1[3]) * u1[3]);
                *(v4u*)rowp = w;
            }
    }
};
struct EpiResid {
    static constexpr bool PERM = true, AFTER_DRAIN = false;
    const float* base0; const float* base1; float* out; const float* mods; int modrow; float scale;
    __device__ __forceinline__ void operator()(const pg8::f32x4 (&acc)[2][2][4][2], const pg8::Unit& u, int wr, int wc, int fr, int fq) const {
        const int mi = u.pm < 32 ? 0 : 1 + ((u.pm - 32) >> 3);
        const float* mrow = mods + (size_t)(mi * NMOD + modrow) * DM;
        const int row0 = u.pm * 256 + wr * 64 + fr, col0 = u.pn * 256 + wc * 32 + 8 * fq;
        f32x4 mv[2][2];
#pragma unroll
        for (int bj = 0; bj < 2; ++bj)
#pragma unroll
            for (int n = 0; n < 2; ++n) mv[bj][n] = *(const f32x4*)(mrow + col0 + bj * 128 + 4 * n) * scale;
#pragma unroll
        for (int ai = 0; ai < 2; ++ai)
#pragma unroll
            for (int m = 0; m < 4; ++m) {
                const int row = row0 + ai * 128 + m * 16;
                const float* bp = (row < NP ? base0 + (size_t)row * DM : base1 + (size_t)(row - NP) * DM) + col0;
                float* op = out + (size_t)row * DM + col0;
#pragma unroll
                for (int bj = 0; bj < 2; ++bj)
#pragma unroll
                    for (int n = 0; n < 2; ++n) {
                        const f32x4 b = *(const f32x4*)(bp + bj * 128 + 4 * n);
                        *(f32x4*)(op + bj * 128 + 4 * n) = b + mv[bj][n] * acc[ai][bj][m][n];
                    }
            }
    }
};

__device__ __forceinline__ void phase_mods(LAS unsigned char* L, const float* c, const float* c_ctx, const float* w_ada, const float* b_ada, float* MODS, int tid) {
    LAS float* SC = (LAS float*)L;
    LAS float* RED = (LAS float*)(L + 20480);
    for (int i = tid; i < NMODROW * DM; i += 512) { const int j = i >> 10, k = i & 1023; const float v = j == 0 ? c_ctx[k] : c[(j - 1) * DM + k]; SC[i] = v / (1.f + expf(-v)); }
    __syncthreads();
    for (int cb = blockIdx.x; cb < 256; cb += gridDim.x) {
        const int n0 = cb * 36;
        if (tid < 504) {
            const int ci = tid % 36, kg = tid / 36;
            float a0 = 0.f, a1 = 0.f, a2 = 0.f, a3 = 0.f, a4 = 0.f;
#pragma unroll 8
            for (int k = kg; k < DM; k += 14) {
                const float w = w_ada[(size_t)k * (NMOD * DM) + n0 + ci];
                a0 += SC[k] * w; a1 += SC[DM + k] * w; a2 += SC[2 * DM + k] * w; a3 += SC[3 * DM + k] * w; a4 += SC[4 * DM + k] * w;
            }
            LAS float* r = RED + (kg * 36 + ci) * 5; r[0] = a0; r[1] = a1; r[2] = a2; r[3] = a3; r[4] = a4;
        }
        __syncthreads();
        if (tid < 180) {
            const int ci = tid % 36, j = tid / 36; float s = b_ada[n0 + ci];
#pragma unroll
            for (int kg = 0; kg < 14; ++kg) s += RED[(kg * 36 + ci) * 5 + j];
            MODS[(size_t)j * (NMOD * DM) + n0 + ci] = s;
        }
        __syncthreads();
    }
}
__device__ __forceinline__ void transpose_item(const float* W, int K, int N, bf16* WT, int k0, int n0, int drow0, LAS float* scr, int lane) {
#pragma unroll 8
    for (int i = 0; i < 32; ++i) { const int kk = 2 * i + (lane >> 5); scr[kk * 33 + (lane & 31)] = W[(size_t)(k0 + kk) * N + n0 + (lane & 31)]; }
    asm volatile("s_waitcnt lgkmcnt(0)" ::: "memory");
    const int c = lane & 7;
#pragma unroll
    for (int j = 0; j < 4; ++j) { const int n = (lane >> 3) + 8 * j; const LAS float* s = scr + (8 * c) * 33 + n;
        v4u o; o.x = pk2(s[0 * 33], s[1 * 33]); o.y = pk2(s[2 * 33], s[3 * 33]); o.z = pk2(s[4 * 33], s[5 * 33]); o.w = pk2(s[6 * 33], s[7 * 33]);
        *(v4u*)(WT + (size_t)(drow0 + n) * K + k0 + 8 * c) = o; }
    asm volatile("s_waitcnt lgkmcnt(0)" ::: "memory");
}
struct WPtrs { const float *w1a, *w3a, *w2a, *win, *wout, *w1b, *w3b, *w2b; };
__device__ __forceinline__ void phase_weights(LAS unsigned char* L, const WPtrs& W, unsigned char* ws, int gw, int NGW, int wave, int lane, int gtid, int nthr) {
    LAS float* scr = (LAS float*)(L + 32768 + wave * 8704);
    constexpr int I_UP = 16 * 88, I_DN = 44 * 32, I_IN = 16 * 97, I_OUT = 16 * 32;
    constexpr int NITEMS = 4 * I_UP + 2 * I_DN + I_IN + I_OUT;
    for (int it = gw; it < NITEMS; it += NGW) {
        int r = it;
        if (r < 4 * I_UP) {
            const int which = r / I_UP; r -= which * I_UP; const int kb = r / 88, nb = r % 88, n0 = nb * 32;
            const float* src = which == 0 ? W.w1a : which == 1 ? W.w3a : which == 2 ? W.w1b : W.w3b;
            bf16* dst = (bf16*)(ws + (which < 2 ? WS_WUP1 : WS_WUP2));
            transpose_item(src, DM, DFF, dst, kb * 64, n0, (n0 >> 7) * 256 + (which & 1) * 128 + (n0 & 127), scr, lane); continue; }
        r -= 4 * I_UP;
        if (r < 2 * I_DN) { const int which = r / I_DN; r -= which * I_DN; const int kb = r / 32, nb = r % 32;
            transpose_item(which == 0 ? W.w2a : W.w2b, DFF, DM, (bf16*)(ws + (which == 0 ? WS_WDN1 : WS_WDN2)), kb * 64, nb * 32, nb * 32, scr, lane); continue; }
        r -= 2 * I_DN;
        if (r < I_IN) { const int kb = r / 97, nb = r % 97; transpose_item(W.win, DM, NIN, (bf16*)(ws + WS_WIN), kb * 64, nb * 32, nb * 32, scr, lane); continue; }
        r -= I_IN;
        { const int kb = r / 32, nb = r % 32; transpose_item(W.wout, DM, DM, (bf16*)(ws + WS_WOUT), kb * 64, nb * 32, nb * 32, scr, lane); }
    }
    v4u* z = (v4u*)(ws + WS_WIN + (size_t)NIN * DM * 2);
    for (int i = gtid; i < (NINP - NIN) * DM / 8; i += nthr) z[i] = (v4u){0u, 0u, 0u, 0u};
}

__device__ __forceinline__ void phase_normmod(const float* x0, const float* x1, const float* gain, const float* MODS, int i_shift, int i_scale, bf16* H, int gw, int NGW, int lane) {
    for (int m = gw; m < NTOK; m += NGW) {
        const float* xrow = m < NP ? x0 + (size_t)m * DM : x1 + (size_t)(m - NP) * DM;
        const int mi = m < NP ? 0 : 1 + ((m - NP) >> 11);
        const f32x4* xr = (const f32x4*)xrow + lane;
        const f32x4* gp = (const f32x4*)gain + lane;
        const f32x4* sh = (const f32x4*)(MODS + (size_t)(mi * NMOD + i_shift) * DM) + lane;
        const f32x4* sc = (const f32x4*)(MODS + (size_t)(mi * NMOD + i_scale) * DM) + lane;
        f32x4 v[4]; float s = 0.f;
#pragma unroll
        for (int j = 0; j < 4; ++j) { v[j] = xr[64 * j]; s += (v[j].x * v[j].x + v[j].y * v[j].y) + (v[j].z * v[j].z + v[j].w * v[j].w); }
        const float rstd = rsqrtf(wave_sum(s) * (1.f / DM) + EPS);
        unsigned long long* o8 = (unsigned long long*)(H + (size_t)m * DM) + lane;
#pragma unroll
        for (int j = 0; j < 4; ++j) {
            const f32x4 g = gp[64 * j], a = sc[64 * j], b = sh[64 * j];
            const f32x4 y = (v[j] * rstd * g) * (a + 1.f) + b;
            o8[64 * j] = (unsigned long long)pk2(y.x, y.y) | ((unsigned long long)pk2(y.z, y.w) << 32);
        }
    }
}
__device__ __forceinline__ void phase_final_norm(float* X, const float* gain, int gw, int NGW, int lane) {
    for (int m = gw; m < NTOK; m += NGW) {
        f32x4* xr = (f32x4*)(X + (size_t)m * DM) + lane;
        const f32x4* gp = (const f32x4*)gain + lane;
        f32x4 v[4]; float s = 0.f;
#pragma unroll
        for (int j = 0; j < 4; ++j) { v[j] = xr[64 * j]; s += (v[j].x * v[j].x + v[j].y * v[j].y) + (v[j].z * v[j].z + v[j].w * v[j].w); }
        const float rstd = rsqrtf(wave_sum(s) * (1.f / DM) + EPS);
#pragma unroll
        for (int j = 0; j < 4; ++j) xr[64 * j] = v[j] * rstd * gp[64 * j];
    }
}

constexpr int G_LR = 0, G_WD = 8192, G_BD = 16384, G_PT = 16896, G_CUM = 18944;
constexpr int G_QK = 51712;
constexpr int G_VT = 88576;
constexpr int G_SC = 107008;
constexpr int G_SSQ = 116224;
constexpr int G_ST = 0;
constexpr int RS = 72;

struct CumIn { v2u lr; f32x4 wd; float bd; };
__device__ __forceinline__ CumIn gla_cum_load(const bf16* PROJ, const float* w_decay, const float* b_decay, int row0, int h, int tid) {
    CumIn ci;
    { const int t = tid >> 3, part = tid & 7; ci.lr = *(const v2u*)(PROJ + (size_t)(row0 + t) * NINP + PC_LR + 4 * part); }
    { const int idx = tid * 4, dir = idx >> 10, j = (idx >> 6) & 15, d = idx & 63; ci.wd = *(const f32x4*)(w_decay + dir * 4096 + j * 256 + h * 64 + d); }
    ci.bd = b_decay[((tid >> 6) & 1) * 256 + h * 64 + (tid & 63)];
    return ci;
}
__device__ __forceinline__ void gla_cum_compute(LAS unsigned char* L, const CumIn& ci, int tid) {
    LAS float* LR = (LAS float*)(L + G_LR); LAS float* WD = (LAS float*)(L + G_WD); LAS float* BD = (LAS float*)(L + G_BD);
    LAS float* PT = (LAS float*)(L + G_PT); LAS float* CUM = (LAS float*)(L + G_CUM);
    { const int t = tid >> 3, part = tid & 7;
      LAS float* dst = LR + ((part >> 2) * 64 + t) * 16 + (part & 3) * 4;
      *(LAS f32x4*)dst = (f32x4){bflo(ci.lr.x), bfhi(ci.lr.x), bflo(ci.lr.y), bfhi(ci.lr.y)}; }
    *(LAS f32x4*)(WD + tid * 4) = ci.wd;
    if (tid < 128) BD[tid] = ci.bd;
    __syncthreads();
    const int d = tid & 63, dir = (tid >> 6) & 1, part = tid >> 7;
    {
        float wreg[16];
#pragma unroll
        for (int j = 0; j < 16; ++j) wreg[j] = WD[dir * 1024 + j * 64 + d];
        const float bias = BD[dir * 64 + d];
        float run = 0.f;
#pragma unroll
        for (int i = 0; i < 16; ++i) {
            const int t = dir == 0 ? part * 16 + i : part * 16 + 15 - i;
            const LAS f32x4* lr = (const LAS f32x4*)(LR + (dir * 64 + t) * 16);
            float x = bias;
#pragma unroll
            for (int j = 0; j < 4; ++j) { const f32x4 v = lr[j]; x += v[0] * wreg[4 * j] + v[1] * wreg[4 * j + 1] + v[2] * wreg[4 * j + 2] + v[3] * wreg[4 * j + 3]; }
            const float la = (fminf(x, 0.f) - __logf(1.f + __expf(-fabsf(x)))) * (1.f / 16.f);
            run += la; CUM[(dir * 64 + t) * 64 + d] = run;
        }
        PT[(dir * 4 + part) * 64 + d] = run;
    }
    __syncthreads();
    {
        float off = 0.f;
#pragma unroll
        for (int p = 0; p < 4; ++p) { const float v = PT[(dir * 4 + p) * 64 + d]; if (dir == 0 ? p < part : p > part) off += v; }
#pragma unroll
        for (int i = 0; i < 16; ++i) CUM[(dir * 64 + part * 16 + i) * 64 + d] += off;
    }
    __syncthreads();
}
struct VIn { v4u a, b; };
__device__ __forceinline__ VIn gla_v_load(const bf16* PROJ, int row0, int h, int tid) {
    const int s = tid >> 3, e0 = (tid & 7) * 16;
    const v4u* src = (const v4u*)(PROJ + (size_t)(row0 + s) * NINP + PC_V + h * 128 + e0);
    VIn v; v.a = src[0]; v.b = src[1]; return v;
}
__device__ __forceinline__ void gla_v_store(LAS unsigned char* L, const VIn& v, int tid) {
    LAS bf16* VT = (LAS bf16*)(L + G_VT);
    const int s = tid >> 3, e0 = (tid & 7) * 16;
    const unsigned w[8] = {v.a.x, v.a.y, v.a.z, v.a.w, v.b.x, v.b.y, v.b.z, v.b.w};
#pragma unroll
    for (int i = 0; i < 8; ++i) { VT[(e0 + 2 * i) * RS + s] = (bf16)(w[i] & 0xffffu); VT[(e0 + 2 * i + 1) * RS + s] = (bf16)(w[i] >> 16); }
}
#define MFMA16(a, b, c) __builtin_amdgcn_mfma_f32_16x16x32_bf16((a), (b), (c), 0, 0, 0)
#define LDFRAG(base, row, kk) (*(const LAS bf16x8*)((base) + (row) * RS + (kk) * 32 + fq * 8))

__device__ __forceinline__ void phase_gla_local(LAS unsigned char* L, const bf16* PROJ, const float* w_decay, const float* b_decay, float* STATE, float* TOT, int tid) {
    const int wave = tid >> 6, lane = tid & 63, fr = lane & 15, fq = lane >> 4;
    LAS float* CUM = (LAS float*)(L + G_CUM); LAS bf16* KT = (LAS bf16*)(L + G_QK); LAS bf16* VT = (LAS bf16*)(L + G_VT);
    for (int unit = blockIdx.x; unit < 1024; unit += gridDim.x) {
        const int gc = unit >> 2, h = unit & 3, row0 = gc * 64;
        const CumIn ci = gla_cum_load(PROJ, w_decay, b_decay, row0, h, tid);
        const int s = tid >> 3, d0 = (tid & 7) * 8;
        const v4u kr = *(const v4u*)(PROJ + (size_t)(row0 + s) * NINP + PC_K + h * 64 + d0);
        const VIn vin = gla_v_load(PROJ, row0, h, tid);
        gla_cum_compute(L, ci, tid);
        { const unsigned w[4] = {kr.x, kr.y, kr.z, kr.w};
#pragma unroll
          for (int i = 0; i < 8; ++i) {
              const int d = d0 + i; const float k = (i & 1) ? bfhi(w[i >> 1]) : bflo(w[i >> 1]);
              const float tf = CUM[(63) * 64 + d], tb = CUM[(64 + 0) * 64 + d];
              const float cf = CUM[s * 64 + d], cb = CUM[(64 + s) * 64 + d];
              const unsigned pf = pk2(k * __expf(tf - cf), 0.f), pb = pk2(k * __expf(tb - cb), 0.f);
              KT[(d) * RS + s] = (bf16)(pf & 0xffffu); KT[(64 + d) * RS + s] = (bf16)(pb & 0xffffu);
          } }
        gla_v_store(L, vin, tid);
        if (tid < 128) { const int dir = tid >> 6, d = tid & 63; TOT[(size_t)((gc * 4 + h) * 2 + dir) * 64 + d] = dir == 0 ? CUM[63 * 64 + d] : CUM[64 * 64 + d]; }
        __syncthreads();
        { const int dir = wave >> 2, dt = wave & 3;
          const bf16x8 q0 = LDFRAG(KT, dir * 64 + dt * 16 + fr, 0), q1 = LDFRAG(KT, dir * 64 + dt * 16 + fr, 1);
          float* dst = STATE + (size_t)((gc * 4 + h) * 2 + dir) * 8192 + (dt * 16 + fr) * 128 + 4 * fq;
#pragma unroll
          for (int i = 0; i < 8; ++i) {
              const bf16x8 p0 = LDFRAG(VT, i * 16 + fr, 0), p1 = LDFRAG(VT, i * 16 + fr, 1);
              f32x4 acc = {0.f, 0.f, 0.f, 0.f};
              acc = MFMA16(p0, q0, acc); acc = MFMA16(p1, q1, acc);
              *(f32x4*)(dst + i * 16) = acc;
          } }
        __syncthreads();
    }
}

__device__ __forceinline__ void scan_chain(int item, bool sample, float* STATE, const float* TOT, const float* state_in, float* new_state) {
    const int e4 = item & 31, d = (item >> 5) & 63, dir = (item >> 11) & 1, h = (item >> 12) & 3, seq = item >> 14;
    const int N = sample ? 32 : 4, gc0 = sample ? 128 + 32 * seq : 4 * seq;
    f32x4 S = {0.f, 0.f, 0.f, 0.f};
    const size_t sidx = (size_t)((seq * 2 + dir) * 4 + h) * 8192 + d * 128 + e4 * 4;
    if (sample) S = *(const f32x4*)(state_in + sidx);
    for (int st = 0; st < N; st += 4) {
        f32x4 loc[4]; float a[4]; float* p[4];
#pragma unroll
        for (int i = 0; i < 4; ++i) {
            const int c = dir == 0 ? st + i : N - 1 - (st + i); const size_t g = (size_t)((gc0 + c) * 4 + h) * 2 + dir;
            p[i] = STATE + g * 8192 + d * 128 + e4 * 4; loc[i] = *(const f32x4*)p[i]; a[i] = TOT[g * 64 + d];
        }
#pragma unroll
        for (int i = 0; i < 4; ++i) { *(f32x4*)p[i] = S; S = S * expf(a[i]) + loc[i]; }
    }
    if (!sample) *(f32x4*)(new_state + sidx) = S;
}
__device__ __forceinline__ void phase_scan(float* STATE, const float* TOT, const float* state_in, float* new_state, int gtid, int nthr) {
    for (int v = gtid; v < 131072; v += nthr) {
        if (v < 65536) { scan_chain(v, true, STATE, TOT, state_in, new_state); scan_chain(v, false, STATE, TOT, state_in, new_state); }
        else { for (int i = 0; i < 7; ++i) scan_chain(65536 + i * 65536 + (v - 65536), false, STATE, TOT, state_in, new_state); }
    }
}

__device__ __forceinline__ void phase_conv(const bf16* PROJ, const float* conv_w, bf16* MIX, int gtid, int nthr) {
#pragma unroll 2
    for (int item = gtid; item < NTOK * 64; item += nthr) {
        const int row = item >> 6, c = (item & 63) * 8;
        const bool sample = row >= NP; const int tl = sample ? (row & 63) : (row & 255), Lseg = sample ? 64 : 256;
        const bool hasp = tl > 0, hasn = tl < Lseg - 1;
        const bf16* prow = PROJ + (size_t)row * NINP;
        const v4u cbv = *(const v4u*)(prow + PC_CB + c);
        const v4u ccm = *(const v4u*)(prow + PC_CC + c), chm = *(const v4u*)(prow + PC_CH + c);
        v4u ccp = {0u, 0u, 0u, 0u}, chp = ccp, ccn = ccp, chn = ccp;
        if (hasp) { ccp = *(const v4u*)(prow - NINP + PC_CC + c); chp = *(const v4u*)(prow - NINP + PC_CH + c); }
        if (hasn) { ccn = *(const v4u*)(prow + NINP + PC_CC + c); chn = *(const v4u*)(prow + NINP + PC_CH + c); }
        const f32x4 w0l = *(const f32x4*)(conv_w + c), w0h = *(const f32x4*)(conv_w + c + 4);
        const f32x4 w1l = *(const f32x4*)(conv_w + 512 + c), w1h = *(const f32x4*)(conv_w + 512 + c + 4);
        const f32x4 w2l = *(const f32x4*)(conv_w + 1024 + c), w2h = *(const f32x4*)(conv_w + 1024 + c + 4);
        const float w0[8] = {w0l[0], w0l[1], w0l[2], w0l[3], w0h[0], w0h[1], w0h[2], w0h[3]};
        const float w1[8] = {w1l[0], w1l[1], w1l[2], w1l[3], w1h[0], w1h[1], w1h[2], w1h[3]};
        const float w2[8] = {w2l[0], w2l[1], w2l[2], w2l[3], w2h[0], w2h[1], w2h[2], w2h[3]};
        const unsigned cbw[4] = {cbv.x, cbv.y, cbv.z, cbv.w}, ccmw[4] = {ccm.x, ccm.y, ccm.z, ccm.w}, chmw[4] = {chm.x, chm.y, chm.z, chm.w};
        const unsigned ccpw[4] = {ccp.x, ccp.y, ccp.z, ccp.w}, chpw[4] = {chp.x, chp.y, chp.z, chp.w}, ccnw[4] = {ccn.x, ccn.y, ccn.z, ccn.w}, chnw[4] = {chn.x, chn.y, chn.z, chn.w};
        unsigned ow[4];
#pragma unroll
        for (int i = 0; i < 4; ++i) {
            const float lo = bflo(cbw[i]) * (w0[2 * i] * bflo(ccpw[i]) * bflo(chpw[i]) + w1[2 * i] * bflo(ccmw[i]) * bflo(chmw[i]) + w2[2 * i] * bflo(ccnw[i]) * bflo(chnw[i]));
            const float hi = bfhi(cbw[i]) * (w0[2 * i + 1] * bfhi(ccpw[i]) * bfhi(chpw[i]) + w1[2 * i + 1] * bfhi(ccmw[i]) * bfhi(chmw[i]) + w2[2 * i + 1] * bfhi(ccnw[i]) * bfhi(chnw[i]));
            ow[i] = pk2(lo, hi);
        }
        *(v4u*)(MIX + (size_t)row * DM + 512 + c) = (v4u){ow[0], ow[1], ow[2], ow[3]};
    }
}
__device__ __forceinline__ void phase_gla_out(LAS unsigned char* L, const bf16* PROJ, const float* w_decay, const float* b_decay, const float* STATE,
                                              const float* gla_norm, bf16* MIX, int tid) {
    const int wave = tid >> 6, lane = tid & 63, fr = lane & 15, fq = lane >> 4;
    LAS float* CUM = (LAS float*)(L + G_CUM);
    LAS bf16* QF = (LAS bf16*)(L + G_QK); LAS bf16* KF = QF + 64 * RS; LAS bf16* QB = KF + 64 * RS; LAS bf16* KB = QB + 64 * RS;
    LAS bf16* VT = (LAS bf16*)(L + G_VT); LAS bf16* SC = (LAS bf16*)(L + G_SC); LAS float* SSQ = (LAS float*)(L + G_SSQ);
    LAS bf16* STF = (LAS bf16*)(L + G_ST); LAS bf16* STB = STF + 128 * RS;
    for (int unit = blockIdx.x; unit < 1024; unit += gridDim.x) {
        const int gc = unit >> 2, h = unit & 3, row0 = gc * 64;
        const int tt = wave & 3, eh = wave >> 2, t = tt * 16 + fr;
        const CumIn ci = gla_cum_load(PROJ, w_decay, b_decay, row0, h, tid);
        const int s = tid >> 3, d0 = (tid & 7) * 8;
        const v4u qr = *(const v4u*)(PROJ + (size_t)(row0 + s) * NINP + PC_Q + h * 64 + d0);
        const v4u kr = *(const v4u*)(PROJ + (size_t)(row0 + s) * NINP + PC_K + h * 64 + d0);
        const VIn vin = gla_v_load(PROJ, row0, h, tid);
        f32x4 st0[2][2], st1[2][2];
#pragma unroll
        for (int dir = 0; dir < 2; ++dir) {
            const float* sp = STATE + (size_t)((gc * 4 + h) * 2 + dir) * 8192;
#pragma unroll
            for (int i = 0; i < 2; ++i) { const int idx = tid + 512 * i, d2 = idx >> 5, e4 = idx & 31;
                st0[dir][i] = *(const f32x4*)(sp + (2 * d2) * 128 + e4 * 4); st1[dir][i] = *(const f32x4*)(sp + (2 * d2 + 1) * 128 + e4 * 4); }
        }
        v2u gr[4];
        { const bf16* grow = PROJ + (size_t)(row0 + t) * NINP + PC_G + h * 128;
#pragma unroll
          for (int i4 = 0; i4 < 4; ++i4) gr[i4] = *(const v2u*)(grow + (eh * 4 + i4) * 16 + 4 * fq); }
        gla_cum_compute(L, ci, tid);
        { const unsigned qw[4] = {qr.x, qr.y, qr.z, qr.w}, kw[4] = {kr.x, kr.y, kr.z, kr.w};
          unsigned oqf[4], okf[4], oqb[4], okb[4];
#pragma unroll
          for (int i = 0; i < 4; ++i) {
              const int d = d0 + 2 * i;
              const float cf0 = CUM[s * 64 + d], cf1 = CUM[s * 64 + d + 1], cb0 = CUM[(64 + s) * 64 + d], cb1 = CUM[(64 + s) * 64 + d + 1];
              const float q0 = bflo(qw[i]) * 0.125f, q1 = bfhi(qw[i]) * 0.125f, k0 = bflo(kw[i]), k1 = bfhi(kw[i]);
              oqf[i] = pk2(q0 * __expf(cf0), q1 * __expf(cf1)); okf[i] = pk2(k0 * __expf(-cf0), k1 * __expf(-cf1));
              oqb[i] = pk2(q0 * __expf(cb0), q1 * __expf(cb1)); okb[i] = pk2(k0 * __expf(-cb0), k1 * __expf(-cb1));
          }
          *(LAS v4u*)(QF + s * RS + d0) = (v4u){oqf[0], oqf[1], oqf[2], oqf[3]}; *(LAS v4u*)(KF + s * RS + d0) = (v4u){okf[0], okf[1], okf[2], okf[3]};
          *(LAS v4u*)(QB + s * RS + d0) = (v4u){oqb[0], oqb[1], oqb[2], oqb[3]}; *(LAS v4u*)(KB + s * RS + d0) = (v4u){okb[0], okb[1], okb[2], okb[3]}; }
        gla_v_store(L, vin, tid);
        __syncthreads();
#pragma unroll
        for (int dir = 0; dir < 2; ++dir) {
            LAS bf16* ST = dir == 0 ? STF : STB;
#pragma unroll
            for (int i = 0; i < 2; ++i) {
                const int idx = tid + 512 * i, d2 = idx >> 5, e4 = idx & 31;
#pragma unroll
                for (int r = 0; r < 4; ++r) *(LAS unsigned*)(ST + (e4 * 4 + r) * RS + 2 * d2) = pk2(st0[dir][i][r], st1[dir][i][r]);
            }
        }
        { const bf16x8 qf0 = LDFRAG(QF, tt * 16 + fr, 0), qf1 = LDFRAG(QF, tt * 16 + fr, 1), qb0 = LDFRAG(QB, tt * 16 + fr, 0), qb1 = LDFRAG(QB, tt * 16 + fr, 1);
#pragma unroll
          for (int j = 0; j < 2; ++j) {
              const int st = (wave >> 2) * 2 + j;
              const bf16x8 kf0 = LDFRAG(KF, st * 16 + fr, 0), kf1 = LDFRAG(KF, st * 16 + fr, 1), kb0 = LDFRAG(KB, st * 16 + fr, 0), kb1 = LDFRAG(KB, st * 16 + fr, 1);
              f32x4 af = {0.f, 0.f, 0.f, 0.f}, ab = {0.f, 0.f, 0.f, 0.f};
              af = MFMA16(kf0, qf0, af); af = MFMA16(kf1, qf1, af);
              ab = MFMA16(kb0, qb0, ab); ab = MFMA16(kb1, qb1, ab);
              const int s0 = st * 16 + 4 * fq;
              float v[4];
#pragma unroll
              for (int r = 0; r < 4; ++r) { const int sx = s0 + r; v[r] = (sx <= t ? af[r] : 0.f) + (sx >= t ? ab[r] : 0.f); }
              *(LAS v2u*)(SC + t * RS + s0) = (v2u){pk2(v[0], v[1]), pk2(v[2], v[3])};
          } }
        __syncthreads();
        f32x4 o[4]; float ssq = 0.f;
        { const bf16x8 a0 = LDFRAG(SC, t, 0), a1 = LDFRAG(SC, t, 1), b0 = LDFRAG(QF, t, 0), b1 = LDFRAG(QF, t, 1), c0 = LDFRAG(QB, t, 0), c1 = LDFRAG(QB, t, 1);
#pragma unroll
          for (int i4 = 0; i4 < 4; ++i4) {
              const int er = (eh * 4 + i4) * 16 + fr;
              f32x4 acc = {0.f, 0.f, 0.f, 0.f};
              acc = MFMA16(LDFRAG(VT, er, 0), a0, acc); acc = MFMA16(LDFRAG(VT, er, 1), a1, acc);
              acc = MFMA16(LDFRAG(STF, er, 0), b0, acc); acc = MFMA16(LDFRAG(STF, er, 1), b1, acc);
              acc = MFMA16(LDFRAG(STB, er, 0), c0, acc); acc = MFMA16(LDFRAG(STB, er, 1), c1, acc);
              o[i4] = acc; ssq += (acc[0] * acc[0] + acc[1] * acc[1]) + (acc[2] * acc[2] + acc[3] * acc[3]);
          } }
        ssq += __shfl_xor(ssq, 16); ssq += __shfl_xor(ssq, 32);
        if (fq == 0) SSQ[eh * 64 + t] = ssq;
        __syncthreads();
        { const float rstd = rsqrtf((SSQ[t] + SSQ[64 + t]) * (1.f / 128.f) + EPS);
          bf16* orow = MIX + (size_t)(row0 + t) * DM + h * 128;
#pragma unroll
          for (int i4 = 0; i4 < 4; ++i4) {
              const int e = (eh * 4 + i4) * 16 + 4 * fq;
              const f32x4 gn = *(const f32x4*)(gla_norm + h * 128 + e);
              const float y0 = o[i4][0] * rstd * gn[0] * silu_f(bflo(gr[i4].x)), y1 = o[i4][1] * rstd * gn[1] * silu_f(bfhi(gr[i4].x));
              const float y2 = o[i4][2] * rstd * gn[2] * silu_f(bflo(gr[i4].y)), y3 = o[i4][3] * rstd * gn[3] * silu_f(bfhi(gr[i4].y));
              *(v2u*)(orow + e) = (v2u){pk2(y0, y1), pk2(y2, y3)};
          } }
        __syncthreads();
    }
}

#define XB_TMO      128
#define XB_XCNT(j)  (256  + 64 * (j))
#define XB_XSUB(j)  (1280 + 64 * (j))
#define XB_XGEN(j)  (2304 + 64 * (j))
#define XB_TOP      3328
#define XB_TOPGEN   3392
#define XCD_BAR_WORDS 3456
#define XB_SPIN_CAP (1u << 18)

__device__ __forceinline__ unsigned xb_ld(unsigned* p)              { return __hip_atomic_load(p, __ATOMIC_RELAXED, __HIP_MEMORY_SCOPE_AGENT); }
__device__ __forceinline__ unsigned xb_add(unsigned* p, unsigned v) { return __hip_atomic_fetch_add(p, v, __ATOMIC_RELAXED, __HIP_MEMORY_SCOPE_AGENT); }
__device__ __forceinline__ unsigned xb_xcc_id() { return (unsigned)__builtin_amdgcn_s_getreg((3 << 11) | 20) & 0xFu; }
#define XB_SPIN(cond, bar) do { unsigned _sp = 0; while (cond) { __builtin_amdgcn_s_sleep(1); \
    if ((++_sp & 255u) == 0u) { if (xb_ld(&(bar)[XB_TMO])) break; if (_sp > XB_SPIN_CAP) { atomicAdd(&(bar)[XB_TMO], 1u); break; } } } } while (0)

struct XcdBarrier {
    unsigned* bar; unsigned x;
    volatile LAS unsigned* st;
};

__device__ __forceinline__ XcdBarrier xcd_barrier_post(unsigned* bar, volatile LAS unsigned* st) {
    XcdBarrier b; b.bar = bar; b.x = xb_xcc_id(); b.st = st;
    if (threadIdx.x == 0) (void)xb_add(&bar[XB_XCNT(b.x)], 1u);
    return b;
}
__device__ __forceinline__ void xcd_barrier_complete(unsigned* bar, unsigned x, unsigned& nloc, unsigned& nx) {
    const unsigned G = gridDim.x * gridDim.y * gridDim.z;
    unsigned sum, cnt, mine, sp = 0u;
    for (;;) {
        sum = 0u; cnt = 0u; mine = 0u;
#pragma unroll
        for (unsigned j = 0; j < 16; ++j) { const unsigned c = xb_ld(&bar[XB_XCNT(j)]); sum += c; cnt += (c > 0u) ? 1u : 0u; mine = (j == x) ? c : mine; }
        if (sum == G) break;
        __builtin_amdgcn_s_sleep(1);
        if ((++sp & 255u) == 0u) { if (xb_ld(&bar[XB_TMO])) break; if (sp > XB_SPIN_CAP) { atomicAdd(&bar[XB_TMO], 1u); break; } }
    }
    nloc = mine > 0u ? mine : 1u; nx = cnt > 0u ? cnt : 1u;
}

__device__ __forceinline__ void xcd_barrier(const XcdBarrier& b) {
    asm volatile("s_waitcnt vmcnt(0)" ::: "memory");
    __syncthreads();
    if (threadIdx.x == 0) {
        unsigned* bar = b.bar;
        __builtin_amdgcn_s_waitcnt(0);
        unsigned nloc = b.st[0], nx = b.st[1];
        if (nloc == 0u) { xcd_barrier_complete(bar, b.x, nloc, nx); b.st[0] = nloc; b.st[1] = nx; }
        const unsigned old = xb_add(&bar[XB_XSUB(b.x)], 1u);
        const unsigned gen = old / nloc;
        if (old + 1u == (gen + 1u) * nloc) {
            __builtin_amdgcn_fence(__ATOMIC_RELEASE, "agent");
            asm volatile("s_waitcnt vmcnt(0)" ::: "memory");
            const unsigned og = xb_add(&bar[XB_TOP], 1u);
            const unsigned tg = og / nx;
            if (og + 1u == (tg + 1u) * nx) xb_add(&bar[XB_TOPGEN], 1u);
            else XB_SPIN(xb_ld(&bar[XB_TOPGEN]) == tg, bar);
            __builtin_amdgcn_fence(__ATOMIC_ACQUIRE, "agent");
            xb_add(&bar[XB_XGEN(b.x)], 1u);
            asm volatile("s_waitcnt vmcnt(0)" ::: "memory");
        } else {
            XB_SPIN(xb_ld(&bar[XB_XGEN(b.x)]) == gen, bar);
            __builtin_amdgcn_fence(__ATOMIC_ACQUIRE, "agent");
            asm volatile("s_waitcnt vmcnt(0)" ::: "memory");
        }
    }
    __syncthreads();
}
struct Args {
    const float *x_prompt, *x_sample, *state_gla, *c, *c_ctx, *w_ada, *b_ada, *norm_ffn1, *w1_ffn1, *w3_ffn1, *w2_ffn1, *norm_mix, *w_in, *w_decay, *b_decay,
                *gla_norm, *conv_w, *w_out, *norm_ffn2, *w1_ffn2, *w3_ffn2, *w2_ffn2, *final_norm;
    float* out; unsigned char* ws;
};

enum { I_XP = 0, I_XS, I_STATE, I_C, I_CCTX, I_WADA, I_BADA, I_NF1, I_W1A, I_W3A, I_W2A, I_NMIX, I_WIN, I_WDEC, I_BDEC, I_GNORM, I_CONVW, I_WOUT, I_NF2, I_W1B, I_W3B, I_W2B, I_FNORM, I_OUT, I_WS };
constexpr int LDS_XST = 140000, LDS_ARGS = 140032;
__device__ __forceinline__ unsigned long long ldarg(LAS unsigned char* L, int i) {
    const unsigned long long v = *(volatile LAS unsigned long long*)(L + LDS_ARGS + 8 * i);
    const unsigned lo = __builtin_amdgcn_readfirstlane((unsigned)v), hi = __builtin_amdgcn_readfirstlane((unsigned)(v >> 32));
    return ((unsigned long long)hi << 32) | lo;
}
#define ARGF(i) ((const float*)ldarg(L, (i)))
#define WSP() ((unsigned char*)ldarg(L, I_WS))
#define OUTP() ((float*)ldarg(L, I_OUT))
#undef GSYNC
#define GSYNC() do { for (int r_ = 0; r_ < REP_SYNC; ++r_) { XcdBarrier xb_; xb_.bar = (unsigned*)(WSP() + WS_BAR); xb_.x = xb_xcc_id(); xb_.st = (volatile LAS unsigned*)(L + LDS_XST); xcd_barrier(xb_); } } while (0)

__global__ void __launch_bounds__(512, 2) mega_fwd(Args A) {
    extern __shared__ __attribute__((aligned(16))) unsigned char lds_raw[];
    LAS unsigned char* L = (LAS unsigned char*)lds_raw;
    const int tid = threadIdx.x, lane = tid & 63, wave = __builtin_amdgcn_readfirstlane(tid >> 6);
    if (A.ws == nullptr) { cg::grid_group grid = cg::this_grid(); grid.sync(); }
    if (tid == 0) {
        LAS unsigned long long* LA = (LAS unsigned long long*)(L + LDS_ARGS);
        LA[I_XP] = (unsigned long long)A.x_prompt; LA[I_XS] = (unsigned long long)A.x_sample; LA[I_STATE] = (unsigned long long)A.state_gla; LA[I_C] = (unsigned long long)A.c;
        LA[I_CCTX] = (unsigned long long)A.c_ctx; LA[I_WADA] = (unsigned long long)A.w_ada; LA[I_BADA] = (unsigned long long)A.b_ada; LA[I_NF1] = (unsigned long long)A.norm_ffn1;
        LA[I_W1A] = (unsigned long long)A.w1_ffn1; LA[I_W3A] = (unsigned long long)A.w3_ffn1; LA[I_W2A] = (unsigned long long)A.w2_ffn1; LA[I_NMIX] = (unsigned long long)A.norm_mix;
        LA[I_WIN] = (unsigned long long)A.w_in; LA[I_WDEC] = (unsigned long long)A.w_decay; LA[I_BDEC] = (unsigned long long)A.b_decay; LA[I_GNORM] = (unsigned long long)A.gla_norm;
        LA[I_CONVW] = (unsigned long long)A.conv_w; LA[I_WOUT] = (unsigned long long)A.w_out; LA[I_NF2] = (unsigned long long)A.norm_ffn2; LA[I_W1B] = (unsigned long long)A.w1_ffn2;
        LA[I_W3B] = (unsigned long long)A.w3_ffn2; LA[I_W2B] = (unsigned long long)A.w2_ffn2; LA[I_FNORM] = (unsigned long long)A.final_norm; LA[I_OUT] = (unsigned long long)A.out;
        LA[I_WS] = (unsigned long long)A.ws;
    }
    if (tid < 2) ((volatile LAS unsigned*)(L + LDS_XST))[tid] = 0u;
    __syncthreads();
    (void)xcd_barrier_post((unsigned*)(WSP() + WS_BAR), (volatile LAS unsigned*)(L + LDS_XST));
#define GW (blockIdx.x * 8 + wave)
#define NGW_ (gridDim.x * 8)
#define GTID (blockIdx.x * 512 + tid)
#define NTHR (gridDim.x * 512)
#define P_MODS ((float*)(WSP() + WS_MODS))
#define P_H ((bf16*)(WSP() + WS_H))
#define P_PROJ ((bf16*)(WSP() + WS_PROJ))
#define P_STATE ((float*)(WSP() + WS_STATE))
#define P_TOT ((float*)(WSP() + WS_TOT))

    for (int r_ = 0; r_ < REP_P0; ++r_) {
    phase_mods(L, ARGF(I_C), ARGF(I_CCTX), ARGF(I_WADA), ARGF(I_BADA), P_MODS, tid);
    { WPtrs W{ARGF(I_W1A), ARGF(I_W3A), ARGF(I_W2A), ARGF(I_WIN), ARGF(I_WOUT), ARGF(I_W1B), ARGF(I_W3B), ARGF(I_W2B)};
      phase_weights(L, W, WSP(), GW, NGW_, wave, lane, GTID, NTHR); }
    __syncthreads(); }
    GSYNC();
    for (int r_ = 0; r_ < REP_NORM; ++r_) phase_normmod(ARGF(I_XP), ARGF(I_XS), ARGF(I_NF1), P_MODS, 0, 1, P_H, GW, NGW_, lane);
    GSYNC();
    { unsigned char* ws = WSP(); pg8::Gemm g{(const bf16*)(ws + WS_H), (const bf16*)(ws + WS_WUP1), NTOK, 2 * DFF, DM}; pg8::StaticOrder S; S.init(NTOK, 2 * DFF, gridDim.x, (int)blockIdx.x);
      EpiSwiglu E{(bf16*)(ws + WS_PROJ), DFF}; pg8::gemm_phase<EpiSwiglu, pg8::StaticOrder, true, true>(L, g, S, E); }
    GSYNC();
    { unsigned char* ws = WSP(); pg8::Gemm g{(const bf16*)(ws + WS_PROJ), (const bf16*)(ws + WS_WDN1), NTOK, DM, DFF}; pg8::StaticOrder S; S.init(NTOK, DM, gridDim.x, (int)blockIdx.x);
      EpiResid E{ARGF(I_XP), ARGF(I_XS), OUTP(), (const float*)(ws + WS_MODS), 2, 0.5f}; pg8::gemm_phase<EpiResid, pg8::StaticOrder, true, true>(L, g, S, E); }
    GSYNC();
    { float* RES = OUTP(); phase_normmod(RES, RES + (size_t)NP * DM, ARGF(I_NMIX), P_MODS, 3, 4, P_H, GW, NGW_, lane); }
    GSYNC();
    { unsigned char* ws = WSP(); pg8::Gemm g{(const bf16*)(ws + WS_H), (const bf16*)(ws + WS_WIN), NTOK, NINP, DM}; pg8::StaticOrder S; S.init(NTOK, NINP, gridDim.x, (int)blockIdx.x);
      pg8::EpiBf16<0> E{(bf16*)(ws + WS_PROJ), NINP, nullptr, 0, 0, 1.f}; pg8::gemm_phase<pg8::EpiBf16<0>, pg8::StaticOrder, true, true>(L, g, S, E); }
    GSYNC();
    for (int r_ = 0; r_ < REP_GLA; ++r_) phase_gla_local(L, P_PROJ, ARGF(I_WDEC), ARGF(I_BDEC), P_STATE, P_TOT, tid);
    GSYNC();
    phase_scan(P_STATE, P_TOT, ARGF(I_STATE), OUTP() + (size_t)NTOK * DM, GTID, NTHR);
    GSYNC();
    for (int r_ = 0; r_ < REP_GLA; ++r_) { phase_conv(P_PROJ, ARGF(I_CONVW), P_H, GTID, NTHR); phase_gla_out(L, P_PROJ, ARGF(I_WDEC), ARGF(I_BDEC), P_STATE, ARGF(I_GNORM), P_H, tid); }
    GSYNC();
    { unsigned char* ws = WSP(); float* RES = OUTP(); pg8::Gemm g{(const bf16*)(ws + WS_H), (const bf16*)(ws + WS_WOUT), NTOK, DM, DM}; pg8::StaticOrder S; S.init(NTOK, DM, gridDim.x, (int)blockIdx.x);
      EpiResid E{RES, RES + (size_t)NP * DM, RES, (const float*)(ws + WS_MODS), 5, 1.0f}; pg8::gemm_phase<EpiResid, pg8::StaticOrder, true, true>(L, g, S, E); }
    GSYNC();
    { float* RES = OUTP(); phase_normmod(RES, RES + (size_t)NP * DM, ARGF(I_NF2), P_MODS, 6, 7, P_H, GW, NGW_, lane); }
    GSYNC();
    { unsigned char* ws = WSP(); pg8::Gemm g{(const bf16*)(ws + WS_H), (const bf16*)(ws + WS_WUP2), NTOK, 2 * DFF, DM}; pg8::StaticOrder S; S.init(NTOK, 2 * DFF, gridDim.x, (int)blockIdx.x);
      EpiSwiglu E{(bf16*)(ws + WS_PROJ), DFF}; pg8::gemm_phase<EpiSwiglu, pg8::StaticOrder, true, true>(L, g, S, E); }
    GSYNC();
    { unsigned char* ws = WSP(); float* RES = OUTP(); pg8::Gemm g{(const bf16*)(ws + WS_PROJ), (const bf16*)(ws + WS_WDN2), NTOK, DM, DFF}; pg8::StaticOrder S; S.init(NTOK, DM, gridDim.x, (int)blockIdx.x);
      EpiResid E{RES, RES + (size_t)NP * DM, RES, (const float*)(ws + WS_MODS), 8, 0.5f}; pg8::gemm_phase<EpiResid, pg8::StaticOrder, true, true>(L, g, S, E); }
    GSYNC();
    phase_final_norm(OUTP(), ARGF(I_FNORM), GW, NGW_, lane);
}

extern "C" void kernel_launch(void* const* d_in, const int* in_sizes, int n_in, void* d_out, int out_size, void* d_ws, size_t ws_size, hipStream_t stream) {
    static int grid = 0;
    if (grid == 0) {
        if (n_in != 23 || ws_size < WS_END) { fprintf(stderr, "kernel_launch: unexpected n_in %d / ws %zu\n", n_in, ws_size); grid = -1; return; }
        int dev = 0, cus = 0, per_cu = 0;
        hipGetDevice(&dev);
        hipDeviceGetAttribute(&cus, hipDeviceAttributeMultiprocessorCount, dev);
        if (hipFuncSetAttribute((const void*)mega_fwd, hipFuncAttributeMaxDynamicSharedMemorySize, LDS_BYTES) != hipSuccess) { fprintf(stderr, "kernel_launch: hipFuncSetAttribute failed\n"); grid = -1; return; }
        hipOccupancyMaxActiveBlocksPerMultiprocessor(&per_cu, (const void*)mega_fwd, 512, LDS_BYTES);
        if (per_cu < 1) per_cu = 1;
        (void)hipGetLastError();
        grid = cus;
        if (grid > 256) grid = 256;
    }
    if (grid < 0) return;
    Args a{};
    const float** p = (const float**)&a;
    for (int i = 0; i < 23; ++i) p[i] = (const float*)d_in[i];
    a.out = (float*)d_out; a.ws = (unsigned char*)d_ws;
    (void)hipMemsetAsync((char*)d_ws + WS_BAR, 0, XCD_BAR_WORDS * 4, stream);
    void* args[] = {&a};
    hipError_t e = hipLaunchCooperativeKernel((const void*)mega_fwd, dim3(grid), dim3(512), args, LDS_BYTES, stream);
    if (e != hipSuccess) fprintf(stderr, "cooperative launch failed: %s (grid %d)\n", hipGetErrorString(e), grid);
}
```

```cpp
#include <hip/hip_runtime.h>
#include <hip/hip_cooperative_groups.h>
#include <cstdio>
#include <cstdint>
namespace cg = cooperative_groups;
namespace pg8 {
#define PG8_LAS __attribute__((address_space(3)))
typedef unsigned short bf16_t;
typedef short bf16x8 __attribute__((ext_vector_type(8)));
typedef float f32x4 __attribute__((ext_vector_type(4)));
typedef unsigned u32x4 __attribute__((ext_vector_type(4)));
constexpr int BM = 256, BK = 64, HALF = 128, HTB = HALF * BK * 2  , STAGE_BYTES = 8 * HTB, NXCD = 8, WGM = 8;

__host__ __device__ __forceinline__ int lds_byte(int r, int c) { const int st = (r >> 4) * 2 + (c >> 5), rr = r & 15, cc = c & 31, ob = rr * 64 + cc * 2; return st * 1024 + (ob ^ (((ob >> 9) & 1) << 5)); }
__host__ __device__ __forceinline__ void stage_rc(int b, int& R, int& C) { const int st = b / 1024, sb = b % 1024, swz = sb ^ (((sb >> 9) & 1) << 5); R = (st >> 1) * 16 + swz / 64; C = (st & 1) * 32 + (swz % 64) / 2; }
__host__ __device__ __forceinline__ int perm32(int rho) { const int n = rho >> 4, i = rho & 15; return 8 * (i >> 2) + 4 * n + (i & 3); }

struct Unit { int pm, pn; };
struct Gemm { const bf16_t* A; const bf16_t* Bt; int M, N, K; };

struct StaticOrder {
    int nM, nN, nwg, G, c;
    __host__ __device__ void init(int M, int N, int G_, int c_) { nM = M / BM; nN = N / BM; nwg = nM * nN; G = G_; c = c_; }
    __host__ __device__ bool next(int i, Unit& u) const {
        const long L = (long)i * G + c; if (L >= nwg) return false;
        int wgid = (int)L; { const int q = nwg / NXCD, r = nwg % NXCD, xcd = wgid % NXCD, off = wgid / NXCD; wgid = (xcd < r ? xcd * (q + 1) : r * (q + 1) + (xcd - r) * q) + off; }
        const int nig = WGM * nN, gid = wgid / nig, fm = gid * WGM, gsz = (nM - fm) < WGM ? (nM - fm) : WGM;
        u.pm = fm + ((wgid % nig) % gsz); u.pn = (wgid % nig) / gsz; return true;
    }
    __device__ __forceinline__ void a_ready(const Unit&) const {}
    __device__ __forceinline__ void done(const Unit&) const {}
};

__device__ __forceinline__ unsigned cvt_pk_bf16(float lo, float hi) { unsigned r; asm volatile("v_cvt_pk_bf16_f32 %0, %1, %2" : "=v"(r) : "v"(lo), "v"(hi)); return r; }
typedef float f32x2 __attribute__((ext_vector_type(2)));
__device__ __forceinline__ f32x2 gelu_pk(f32x2 v) {
    const f32x2 av = __builtin_elementwise_abs(v), d = av * 0.2316418882f + 1.0f;
    f32x2 t; t.x = __builtin_amdgcn_rcpf(d.x); t.y = __builtin_amdgcn_rcpf(d.y);
    f32x2 q = t * 0.5307027145f + (-0.7265760135f); q = q * t + 0.7107068705f; q = q * t + (-0.142248368f); q = q * t + 0.127414796f; q = q * t;
    const f32x2 s = (v * v) * (-0.72134752044f);
    f32x2 e; e.x = __builtin_amdgcn_exp2f(s.x); e.y = __builtin_amdgcn_exp2f(s.y);
    const f32x2 m = v * (q * e), r = v - m;
    f32x2 o; o.x = v.x < 0.f ? m.x : r.x; o.y = v.y < 0.f ? m.y : r.y; return o;
}

template <int ACT  > struct EpiBf16 {
    static constexpr bool PERM = true, AFTER_DRAIN = false; static_assert(ACT == 0 || ACT == 1, "EpiBf16: ACT is 0 (none) or 1 (gelu_pk)");
    bf16_t* O; int ldc; const float* bias; int split_cols; size_t split_stride; float scale0;
    __device__ __forceinline__ void operator()(const f32x4 (&acc)[2][2][4][2], const Unit& u, int wr, int wc, int fr, int fq) const {
        const int row0 = u.pm * BM + wr * 64 + fr; int colt = u.pn * BM; bf16_t* base = O;
        float sc = 1.f; if (split_cols) { const int t = colt / split_cols; base += (size_t)t * split_stride; colt -= t * split_cols; if (t == 0) sc = scale0; }
        const int col0 = colt + wc * 32 + 8 * fq, bcol0 = u.pn * BM + wc * 32 + 8 * fq;
        f32x4 bv[2][2];
#pragma unroll
        for (int bj = 0; bj < 2; ++bj)
#pragma unroll
            for (int n = 0; n < 2; ++n) bv[bj][n] = bias ? *(const f32x4*)(bias + bcol0 + bj * HALF + 4 * n) : (f32x4){0.f, 0.f, 0.f, 0.f};
#pragma unroll
        for (int ai = 0; ai < 2; ++ai)
#pragma unroll
            for (int m = 0; m < 4; ++m) { bf16_t* rowp = base + (size_t)(row0 + ai * HALF + m * 16) * ldc + col0;
#pragma unroll
                for (int bj = 0; bj < 2; ++bj) { f32x4 v0 = acc[ai][bj][m][0] + bv[bj][0], v1 = acc[ai][bj][m][1] + bv[bj][1];
                    if (ACT == 1) { f32x2 a = gelu_pk((f32x2){v0[0], v0[1]}), b = gelu_pk((f32x2){v0[2], v0[3]}), c = gelu_pk((f32x2){v1[0], v1[1]}), d = gelu_pk((f32x2){v1[2], v1[3]});
                        v0 = (f32x4){a.x, a.y, b.x, b.y}; v1 = (f32x4){c.x, c.y, d.x, d.y}; }
                    v0 = v0 * sc; v1 = v1 * sc; u32x4 w; w.x = cvt_pk_bf16(v0[0], v0[1]); w.y = cvt_pk_bf16(v0[2], v0[3]); w.z = cvt_pk_bf16(v1[0], v1[1]); w.w = cvt_pk_bf16(v1[2], v1[3]);
                    *(u32x4*)(rowp + bj * HALF) = w; } }
    }
};

template <class Epi, class Sched, bool ALIGN_EPI = false, bool SP2 = false>
__device__ __forceinline__ void gemm_phase(PG8_LAS unsigned char* lds, const Gemm g, const Sched& S, const Epi& E) {
    const int tid = threadIdx.x, wid = __builtin_amdgcn_readfirstlane(tid >> 6), lane = tid & 63, wr = wid >> 2, wc = wid & 3, fr = lane & 15, fq = lane >> 4;
    const int K = g.K, nt = K / BK;
    unsigned voffA[2], voffB[2];
#pragma unroll
    for (int i = 0; i < 2; ++i) { int R, C; stage_rc(tid * 16 + i * 8192, R, C); const int Rb = Epi::PERM ? ((R & ~31) + perm32(R & 31)) : R;
        voffA[i] = (unsigned)(R * K + C) * 2u; voffB[i] = (unsigned)(Rb * K + C) * 2u; }
    const size_t kstep = (size_t)(BK * 2);
    const size_t hstep = (size_t)HALF * K * 2;
    const size_t tstep = 2 * hstep;
    const unsigned ldsw = (unsigned)wid * 1024u;
    const int aoff = lds_byte(wr * 64 + fr, fq * 8), boff = lds_byte(wc * 32 + fr, fq * 8);
#define PG8_SA(b, h) (((b) * 2 + (h)) * HTB)
#define PG8_SB(b, h) ((4 + (b) * 2 + (h)) * HTB)
#define PG8_STAGE(bufoff, gbase, voff) do { _Pragma("unroll") for (int _i = 0; _i < 2; ++_i) \
        __builtin_amdgcn_global_load_lds((const unsigned*)((const char*)(gbase) + (voff)[_i]), (PG8_LAS unsigned*)(lds + (bufoff) + ldsw + _i * 8192), 16, 0, 0); } while (0)
#define PG8_LDA(dst, b, h) do { _Pragma("unroll") for (int m = 0; m < 4; ++m) _Pragma("unroll") for (int k = 0; k < 2; ++k) dst[m][k] = *(const PG8_LAS bf16x8*)(lds + PG8_SA(b, h) + aoff + m * 2048 + k * 1024); } while (0)
#define PG8_LDB(dst, b, h) do { _Pragma("unroll") for (int n = 0; n < 2; ++n) _Pragma("unroll") for (int k = 0; k < 2; ++k) dst[n][k] = *(const PG8_LAS bf16x8*)(lds + PG8_SB(b, h) + boff + n * 2048 + k * 1024); } while (0)
#define PG8_MMA(ai, bj, At, Bt) do { __builtin_amdgcn_s_setprio(1); _Pragma("unroll") for (int m = 0; m < 4; ++m) _Pragma("unroll") for (int n = 0; n < 2; ++n) _Pragma("unroll") for (int k = 0; k < 2; ++k) \
        acc[ai][bj][m][n] = __builtin_amdgcn_mfma_f32_16x16x32_bf16(Bt[n][k], At[m][k], acc[ai][bj][m][n], 0, 0, 0); __builtin_amdgcn_s_setprio(0); } while (0)
#define PG8_WAIT_V(n) asm volatile("s_waitcnt vmcnt(" #n ")" ::: "memory")
#define PG8_WAIT_L(n) asm volatile("s_waitcnt lgkmcnt(" #n ")" ::: "memory")
#define PG8_BAR __builtin_amdgcn_s_barrier()
#define PG8_SCHED __builtin_amdgcn_sched_barrier(0)
    Unit cur, nxt; int ui = 0;
    if (!S.next(0, cur)) return;
    f32x4 acc[2][2][4][2];
#pragma unroll
    for (int a = 0; a < 2; ++a)
#pragma unroll
        for (int b = 0; b < 2; ++b)
#pragma unroll
            for (int m = 0; m < 4; ++m)
#pragma unroll
                for (int n = 0; n < 2; ++n) acc[a][b][m][n] = (f32x4){0.f, 0.f, 0.f, 0.f};
    bf16x8 At[4][2], B0[2][2], B1[2][2];
    const char* cA = (const char*)g.A + (size_t)cur.pm * tstep; const char* cB = (const char*)g.Bt + (size_t)cur.pn * tstep;
    S.a_ready(cur);
    if constexpr (SP2) {
        PG8_STAGE(PG8_SB(0, 0), cB, voffB); PG8_STAGE(PG8_SB(0, 1), cB + hstep, voffB); PG8_STAGE(PG8_SA(0, 0), cA, voffA); PG8_STAGE(PG8_SA(0, 1), cA + hstep, voffA);
        if (wr == 1) PG8_BAR;
        PG8_WAIT_V(2); PG8_BAR;
        PG8_STAGE(PG8_SB(1, 0), cB + kstep, voffB); PG8_STAGE(PG8_SA(1, 0), cA + kstep, voffA); PG8_STAGE(PG8_SB(1, 1), cB + hstep + kstep, voffB);
        PG8_WAIT_V(6); PG8_BAR;
    } else {
        PG8_STAGE(PG8_SB(0, 0), cB, voffB); PG8_STAGE(PG8_SA(0, 0), cA, voffA); PG8_STAGE(PG8_SB(0, 1), cB + hstep, voffB); PG8_STAGE(PG8_SA(0, 1), cA + hstep, voffA);
        if (wr == 1) PG8_BAR;
        PG8_WAIT_V(4); PG8_BAR;
        PG8_STAGE(PG8_SB(1, 0), cB + kstep, voffB); PG8_STAGE(PG8_SA(1, 0), cA + kstep, voffA); PG8_STAGE(PG8_SB(1, 1), cB + hstep + kstep, voffB);
        PG8_WAIT_V(6); PG8_BAR;
    }
    for (;;) {
        const bool has_next = S.next(ui + 1, nxt);
        const char* nA = has_next ? (const char*)g.A + (size_t)nxt.pm * tstep : cA; const char* nB = has_next ? (const char*)g.Bt + (size_t)nxt.pn * tstep : cB;
        for (int t = 0; t < nt; t += 2) {
            const bool last = (t == nt - 2);
            const char* a1 = cA + (size_t)(t + 1) * kstep;
            const char* a2 = last ? nA : cA + (size_t)(t + 2) * kstep; const char* b2 = last ? nB : cB + (size_t)(t + 2) * kstep;
            const char* a3 = a2 + kstep; const char* b3 = b2 + kstep;
            if (last && has_next) S.a_ready(nxt);
            if constexpr (SP2) {
            PG8_LDB(B0, 0, 0); PG8_LDB(B1, 0, 1); PG8_SCHED; PG8_LDA(At, 0, 0); PG8_STAGE(PG8_SA(1, 1), a1 + hstep, voffA);
            PG8_WAIT_V(8); PG8_WAIT_L(0); PG8_BAR; PG8_MMA(0, 0, At, B0); PG8_MMA(0, 1, At, B1); PG8_BAR; PG8_SCHED;
            PG8_LDA(At, 0, 1); PG8_STAGE(PG8_SB(0, 0), b2, voffB); PG8_STAGE(PG8_SB(0, 1), b2 + hstep, voffB); PG8_STAGE(PG8_SA(0, 0), a2, voffA);
            PG8_WAIT_V(8); PG8_WAIT_L(0); PG8_BAR; PG8_MMA(1, 0, At, B0); PG8_MMA(1, 1, At, B1); PG8_BAR; PG8_SCHED;
            PG8_LDB(B0, 1, 0); PG8_LDB(B1, 1, 1); PG8_SCHED; PG8_LDA(At, 1, 0); PG8_STAGE(PG8_SA(0, 1), a2 + hstep, voffA);
            PG8_WAIT_V(8); PG8_WAIT_L(0); PG8_BAR; PG8_MMA(0, 0, At, B0); PG8_MMA(0, 1, At, B1); PG8_BAR; PG8_SCHED;
            PG8_LDA(At, 1, 1); PG8_STAGE(PG8_SB(1, 0), b3, voffB); PG8_STAGE(PG8_SB(1, 1), b3 + hstep, voffB); PG8_STAGE(PG8_SA(1, 0), a3, voffA);
            PG8_WAIT_V(8); PG8_WAIT_L(0); PG8_BAR; PG8_MMA(1, 0, At, B0); PG8_MMA(1, 1, At, B1); PG8_BAR; PG8_SCHED;
            } else {
            PG8_LDB(B0, 0, 0); PG8_SCHED; PG8_LDA(At, 0, 0); PG8_STAGE(PG8_SA(1, 1), a1 + hstep, voffA);
            PG8_WAIT_L(8); PG8_BAR; PG8_WAIT_L(0); PG8_MMA(0, 0, At, B0); PG8_BAR; PG8_SCHED;
            PG8_LDB(B1, 0, 1); PG8_STAGE(PG8_SB(0, 0), b2, voffB);
            PG8_BAR; PG8_WAIT_L(0); PG8_MMA(0, 1, At, B1); PG8_BAR;
            PG8_LDA(At, 0, 1); PG8_STAGE(PG8_SA(0, 0), a2, voffA);
            PG8_BAR; PG8_WAIT_L(0); PG8_MMA(1, 0, At, B0); PG8_BAR; PG8_SCHED;
            PG8_STAGE(PG8_SB(0, 1), b2 + hstep, voffB);
            PG8_WAIT_V(6); PG8_BAR; PG8_MMA(1, 1, At, B1); PG8_BAR;
            PG8_LDB(B0, 1, 0); PG8_SCHED; PG8_LDA(At, 1, 0); PG8_STAGE(PG8_SA(0, 1), a2 + hstep, voffA);
            PG8_WAIT_L(8); PG8_BAR; PG8_WAIT_L(0); PG8_MMA(0, 0, At, B0); PG8_BAR; PG8_SCHED;
            PG8_LDB(B1, 1, 1); PG8_STAGE(PG8_SB(1, 0), b3, voffB);
            PG8_BAR; PG8_WAIT_L(0); PG8_MMA(0, 1, At, B1); PG8_BAR;
            PG8_LDA(At, 1, 1); PG8_STAGE(PG8_SA(1, 0), a3, voffA);
            PG8_BAR; PG8_WAIT_L(0); PG8_MMA(1, 0, At, B0); PG8_BAR; PG8_SCHED;
            PG8_STAGE(PG8_SB(1, 1), b3 + hstep, voffB);
            PG8_WAIT_V(6); PG8_BAR; PG8_MMA(1, 1, At, B1); PG8_BAR;
            }
        }
        if constexpr (ALIGN_EPI) { if (wr == 0) PG8_BAR; }
        if constexpr (!Epi::AFTER_DRAIN) { E(acc, cur, wr, wc, fr, fq); S.done(cur); }
        if (!has_next) break;
#pragma unroll
        for (int a = 0; a < 2; ++a)
#pragma unroll
            for (int b = 0; b < 2; ++b)
#pragma unroll
                for (int m = 0; m < 4; ++m)
#pragma unroll
                    for (int n = 0; n < 2; ++n) acc[a][b][m][n] = (f32x4){0.f, 0.f, 0.f, 0.f};
        cur = nxt; cA = nA; cB = nB; ++ui;
        if constexpr (ALIGN_EPI) { if (wr == 1) PG8_BAR; }
    }
    PG8_WAIT_V(0);
    if constexpr (!ALIGN_EPI) { if (wr == 0) PG8_BAR; }
    PG8_BAR;
    if constexpr (Epi::AFTER_DRAIN) { E.fused(acc, cur, wr, wc, fr, fq, lds, wid, lane); S.done(cur); }
#undef PG8_SA
#undef PG8_SB
#undef PG8_STAGE
#undef PG8_LDA
#undef PG8_LDB
#undef PG8_MMA
#undef PG8_WAIT_V
#undef PG8_WAIT_L
#undef PG8_BAR
#undef PG8_SCHED
}
}

#define GAS __attribute__((address_space(1)))
#define LAS __attribute__((address_space(3)))
typedef unsigned short bf16;
typedef unsigned v4u __attribute__((ext_vector_type(4)));
typedef unsigned v2u __attribute__((ext_vector_type(2)));
typedef float f32x4 __attribute__((ext_vector_type(4)));
typedef short bf16x8 __attribute__((ext_vector_type(8)));

constexpr int NTOK = 16384, NP = 8192, DM = 1024, DFF = 2816, NIN = 3104, NINP = 3072;
constexpr int NMOD = 9, NMODROW = 5;
constexpr float EPS = 1e-6f;
constexpr int PC_Q = 0, PC_K = 256, PC_V = 512, PC_G = 1024, PC_CB = 1536, PC_CC = 2048, PC_CH = 2560;

constexpr size_t MiB = 1u << 20;
constexpr size_t WS_MODS = 0;
constexpr size_t WS_BAR = 512 * 1024;
constexpr size_t WS_WUP1 = 1 * MiB, WS_WDN1 = 12 * MiB, WS_WIN = 18 * MiB, WS_WOUT = 25 * MiB, WS_WUP2 = 27 * MiB, WS_WDN2 = 38 * MiB;
constexpr size_t WS_H = 44 * MiB;
constexpr size_t WS_PROJ = 76 * MiB;
constexpr size_t WS_STATE = 180 * MiB;
constexpr size_t WS_TOT = 244 * MiB;
constexpr size_t WS_LR = 245 * MiB;
constexpr size_t WS_WLR = 24 * MiB + 512 * 1024;
constexpr size_t WS_END = 247 * MiB;
constexpr int LDS_BYTES = 147456;
#ifndef REP_SYNC
#define REP_SYNC 1
#endif
#ifndef REP_P0
#define REP_P0 1
#endif
#ifndef REP_GLA
#define REP_GLA 1
#endif
#ifndef REP_UP
#define REP_UP 1
#endif
#ifndef REP_DN
#define REP_DN 1
#endif
#ifndef REP_IN
#define REP_IN 1
#endif
#ifndef PROBE_MASK
#define PROBE_MASK 0
#endif
#ifndef PROBE_K
#define PROBE_K 4
#endif
#define LDS_PROBE 140320
#define TB(i) do { if ((PROBE_MASK >> (i)) & 1) { if (blockIdx.x == 0 && tid == 0) *(volatile LAS unsigned long long*)(L + LDS_PROBE + 8) = __builtin_amdgcn_s_memrealtime(); } } while (0)
#define TE(i) do { if ((PROBE_MASK >> (i)) & 1) { if (blockIdx.x == 0 && tid == 0) { volatile LAS unsigned long long* q_ = (volatile LAS unsigned long long*)(L + LDS_PROBE); q_[0] = q_[0] + (__builtin_amdgcn_s_memrealtime() - q_[1]); } } } while (0)
#ifndef REP_NORM
#define REP_NORM 1
#endif
#define GSYNC() do { for (int r_ = 0; r_ < REP_SYNC; ++r_) { XcdBarrier xb_; xb_.bar = (unsigned*)(A.ws + WS_BAR); xb_.x = xb_xcc_id(); xb_.st = (volatile LAS unsigned*)(L + 140000); xcd_barrier(xb_); } } while (0)

__device__ __forceinline__ float bf2f(unsigned b) { return __uint_as_float(b << 16); }
__device__ __forceinline__ float bflo(unsigned w) { return __uint_as_float(w << 16); }
__device__ __forceinline__ float bfhi(unsigned w) { return __uint_as_float(w & 0xffff0000u); }
__device__ __forceinline__ unsigned pk2(float lo, float hi) { return pg8::cvt_pk_bf16(lo, hi); }
__device__ __forceinline__ float wave_sum(float v) {
#pragma unroll
    for (int o = 1; o < 64; o <<= 1) v += __shfl_xor(v, o);
    return v;
}
__device__ __forceinline__ float silu_f(float g) { return g * __builtin_amdgcn_rcpf(1.f + __expf(-g)); }

struct EpiSwiglu {
    static constexpr bool PERM = true, AFTER_DRAIN = false;
    bf16* O; int ldc;
    __device__ __forceinline__ void operator()(const pg8::f32x4 (&acc)[2][2][4][2], const pg8::Unit& u, int wr, int wc, int fr, int fq) const {
        const int row0 = u.pm * 256 + wr * 64 + fr, col0 = u.pn * 128 + wc * 32 + 8 * fq;
#pragma unroll
        for (int ai = 0; ai < 2; ++ai)
#pragma unroll
            for (int m = 0; m < 4; ++m) {
                bf16* rowp = O + (size_t)(row0 + ai * 128 + m * 16) * ldc + col0;
                const pg8::f32x4 g0 = acc[ai][0][m][0], g1 = acc[ai][0][m][1], u0 = acc[ai][1][m][0], u1 = acc[ai][1][m][1];
                v4u w;
                w.x = pk2(silu_f(g0[0]) * u0[0], silu_f(g0[1]) * u0[1]);
                w.y = pk2(silu_f(g0[2]) * u0[2], silu_f(g0[3]) * u0[3]);
                w.z = pk2(silu_f(g1[0]) * u1[0], silu_f(g1[1]) * u1[1]);
                w.w = pk2(silu_f(g1[2]) * u1[2], silu_f(g1[3]) * u1[3]);
                *(v4u*)rowp = w;
            }
    }
};
struct EpiResid {
    static constexpr bool PERM = true, AFTER_DRAIN = false;
    const float* base0; const float* base1; float* out; const float* mods; int modrow; float scale;
    __device__ __forceinline__ void operator()(const pg8::f32x4 (&acc)[2][2][4][2], const pg8::Unit& u, int wr, int wc, int fr, int fq) const {
        const int mi = u.pm < 32 ? 0 : 1 + ((u.pm - 32) >> 3);
        const float* mrow = mods + (size_t)(mi * NMOD + modrow) * DM;
        const int row0 = u.pm * 256 + wr * 64 + fr, col0 = u.pn * 256 + wc * 32 + 8 * fq;
        f32x4 mv[2][2];
#pragma unroll
        for (int bj = 0; bj < 2; ++bj)
#pragma unroll
            for (int n = 0; n < 2; ++n) mv[bj][n] = *(const f32x4*)(mrow + col0 + bj * 128 + 4 * n) * scale;
#pragma unroll
        for (int ai = 0; ai < 2; ++ai)
#pragma unroll
            for (int m = 0; m < 4; ++m) {
                const int row = row0 + ai * 128 + m * 16;
                const float* bp = (row < NP ? base0 + (size_t)row * DM : base1 + (size_t)(row - NP) * DM) + col0;
                float* op = out + (size_t)row * DM + col0;
#pragma unroll
                for (int bj = 0; bj < 2; ++bj)
#pragma unroll
                    for (int n = 0; n < 2; ++n) {
                        const f32x4 b = *(const f32x4*)(bp + bj * 128 + 4 * n);
                        *(f32x4*)(op + bj * 128 + 4 * n) = b + mv[bj][n] * acc[ai][bj][m][n];
                    }
            }
    }
};

__device__ __forceinline__ void phase_mods(LAS unsigned char* L, const float* c, const float* c_ctx, const float* w_ada, const float* b_ada, float* MODS, int tid) {
    LAS float* SC = (LAS float*)L;
    LAS float* RED = (LAS float*)(L + 20480);
    for (int i = tid; i < NMODROW * DM; i += 512) { const int j = i >> 10, k = i & 1023; const float v = j == 0 ? c_ctx[k] : c[(j - 1) * DM + k]; SC[i] = v / (1.f + expf(-v)); }
    __syncthreads();
    for (int cb = blockIdx.x; cb < 256; cb += gridDim.x) {
        const int n0 = cb * 36;
        if (tid < 504) {
            const int ci = tid % 36, kg = tid / 36;
            const float* wp = w_ada + (size_t)kg * (NMOD * DM) + n0 + ci;
            float a0 = 0.f, a1 = 0.f, a2 = 0.f, a3 = 0.f, a4 = 0.f;
#pragma unroll
            for (int hb = 0; hb < 2; ++hb) {
                float w[37];
#pragma unroll
                for (int i = 0; i < 37; ++i) { const int ii = hb * 37 + i; w[i] = (ii < 73) ? wp[(size_t)ii * 14 * (NMOD * DM)] : 0.f; }
#pragma unroll
                for (int i = 0; i < 37; ++i) { const int ii = hb * 37 + i; if (ii < 73) { const int k = kg + 14 * ii;
                    a0 += SC[k] * w[i]; a1 += SC[DM + k] * w[i]; a2 += SC[2 * DM + k] * w[i]; a3 += SC[3 * DM + k] * w[i]; a4 += SC[4 * DM + k] * w[i]; } }
            }
            if (kg < 2) { const int k = kg + 14 * 73; const float w = w_ada[(size_t)k * (NMOD * DM) + n0 + ci];
                a0 += SC[k] * w; a1 += SC[DM + k] * w; a2 += SC[2 * DM + k] * w; a3 += SC[3 * DM + k] * w; a4 += SC[4 * DM + k] * w; }
            LAS float* r = RED + (kg * 36 + ci) * 5; r[0] = a0; r[1] = a1; r[2] = a2; r[3] = a3; r[4] = a4;
        }
        __syncthreads();
        if (tid < 180) {
            const int ci = tid % 36, j = tid / 36; float s = b_ada[n0 + ci];
#pragma unroll
            for (int kg = 0; kg < 14; ++kg) s += RED[(kg * 36 + ci) * 5 + j];
            MODS[(size_t)j * (NMOD * DM) + n0 + ci] = s;
        }
        __syncthreads();
    }
}
struct WPtrs { const float *w1a, *w3a, *w2a, *win, *wout, *w1b, *w3b, *w2b; };
struct TItem { const float* src; bf16* dst; int N, K; };
__device__ __forceinline__ TItem titem_decode(int it, const WPtrs& W, unsigned char* ws) {
    constexpr int I_UP = 16 * 88, I_DN = 44 * 32, I_IN = 16 * 97;
    TItem t; int r = it;
    if (r < 4 * I_UP) {
        const int which = r / I_UP; r -= which * I_UP; const int kb = r / 88, nb = r % 88, n0 = nb * 32;
        const float* src = which == 0 ? W.w1a : which == 1 ? W.w3a : which == 2 ? W.w1b : W.w3b;
        t.N = DFF; t.K = DM; t.src = src + (size_t)(kb * 64) * DFF + n0;
        t.dst = (bf16*)(ws + (which < 2 ? WS_WUP1 : WS_WUP2)) + (size_t)((n0 >> 7) * 256 + (which & 1) * 128 + (n0 & 127)) * DM + kb * 64; return t; }
    r -= 4 * I_UP;
    if (r < 2 * I_DN) { const int which = r / I_DN; r -= which * I_DN; const int kb = r / 32, nb = r % 32;
        t.N = DM; t.K = DFF; t.src = (which == 0 ? W.w2a : W.w2b) + (size_t)(kb * 64) * DM + nb * 32;
        t.dst = (bf16*)(ws + (which == 0 ? WS_WDN1 : WS_WDN2)) + (size_t)(nb * 32) * DFF + kb * 64; return t; }
    r -= 2 * I_DN;
    if (r < I_IN) { const int kb = r / 97, nb = r % 97, n0 = nb * 32;
        t.N = NIN; t.K = DM; t.src = W.win + (size_t)(kb * 64) * NIN + n0;
        t.dst = (n0 == 1536 ? (bf16*)(ws + WS_WLR) : (bf16*)(ws + WS_WIN) + (size_t)(n0 < 1536 ? n0 : n0 - 32) * DM) + kb * 64; return t; }
    r -= I_IN;
    { const int kb = r / 32, nb = r % 32; t.N = DM; t.K = DM; t.src = W.wout + (size_t)(kb * 64) * DM + nb * 32; t.dst = (bf16*)(ws + WS_WOUT) + (size_t)(nb * 32) * DM + kb * 64; }
    return t;
}
__device__ __forceinline__ void phase_weights(LAS unsigned char* L, const WPtrs& W, unsigned char* ws, int gw, int NGW, int wave, int lane) {
    LAS float* scr = (LAS float*)(L + 32768 + wave * 8704);
    constexpr int NITEMS = 4 * (16 * 88) + 2 * (44 * 32) + 16 * 97 + 16 * 32;
    const int lr = lane >> 3, lc = lane & 7;
    int it = gw;
    if (it >= NITEMS) return;
    TItem cur = titem_decode(it, W, ws);
    f32x4 v[8];
#pragma unroll
    for (int i = 0; i < 8; ++i) v[i] = *(const f32x4*)(cur.src + (size_t)(8 * i + lr) * cur.N + 4 * lc);
    for (;;) {
        const int it2 = it + NGW; const bool more = it2 < NITEMS;
        TItem nx = cur; f32x4 vn[8];
        if (more) { nx = titem_decode(it2, W, ws);
#pragma unroll
            for (int i = 0; i < 8; ++i) vn[i] = *(const f32x4*)(nx.src + (size_t)(8 * i + lr) * nx.N + 4 * lc); }
#pragma unroll
        for (int i = 0; i < 8; ++i) { LAS float* d = scr + (8 * i + lr) * 33 + 4 * lc; d[0] = v[i][0]; d[1] = v[i][1]; d[2] = v[i][2]; d[3] = v[i][3]; }
        asm volatile("s_waitcnt lgkmcnt(0)" ::: "memory");
#pragma unroll
        for (int j = 0; j < 4; ++j) { const int n = lr + 8 * j; const LAS float* s = scr + (8 * lc) * 33 + n;
            v4u o; o.x = pk2(s[0 * 33], s[1 * 33]); o.y = pk2(s[2 * 33], s[3 * 33]); o.z = pk2(s[4 * 33], s[5 * 33]); o.w = pk2(s[6 * 33], s[7 * 33]);
            *(v4u*)(cur.dst + (size_t)n * cur.K + 8 * lc) = o; }
        asm volatile("s_waitcnt lgkmcnt(0)" ::: "memory");
        if (!more) break;
        it = it2; cur = nx;
#pragma unroll
        for (int i = 0; i < 8; ++i) v[i] = vn[i];
    }
}

__device__ __forceinline__ void phase_normmod(const float* x0, const float* x1, const float* gain, const float* MODS, int i_shift, int i_scale, bf16* H, int gw, int NGW, int lane) {
    for (int m = gw; m < NTOK; m += NGW) {
        const float* xrow = m < NP ? x0 + (size_t)m * DM : x1 + (size_t)(m - NP) * DM;
        const int mi = m < NP ? 0 : 1 + ((m - NP) >> 11);
        const f32x4* xr = (const f32x4*)xrow + lane;
        const f32x4* gp = (const f32x4*)gain + lane;
        const f32x4* sh = (const f32x4*)(MODS + (size_t)(mi * NMOD + i_shift) * DM) + lane;
        const f32x4* sc = (const f32x4*)(MODS + (size_t)(mi * NMOD + i_scale) * DM) + lane;
        f32x4 v[4]; float s = 0.f;
#pragma unroll
        for (int j = 0; j < 4; ++j) { v[j] = xr[64 * j]; s += (v[j].x * v[j].x + v[j].y * v[j].y) + (v[j].z * v[j].z + v[j].w * v[j].w); }
        const float rstd = rsqrtf(wave_sum(s) * (1.f / DM) + EPS);
        unsigned long long* o8 = (unsigned long long*)(H + (size_t)m * DM) + lane;
#pragma unroll
        for (int j = 0; j < 4; ++j) {
            const f32x4 g = gp[64 * j], a = sc[64 * j], b = sh[64 * j];
            const f32x4 y = (v[j] * rstd * g) * (a + 1.f) + b;
            o8[64 * j] = (unsigned long long)pk2(y.x, y.y) | ((unsigned long long)pk2(y.z, y.w) << 32);
        }
    }
}
__device__ __forceinline__ void phase_final_norm(float* X, const float* gain, int gw, int NGW, int lane) {
    for (int m = gw; m < NTOK; m += NGW) {
        f32x4* xr = (f32x4*)(X + (size_t)m * DM) + lane;
        const f32x4* gp = (const f32x4*)gain + lane;
        f32x4 v[4]; float s = 0.f;
#pragma unroll
        for (int j = 0; j < 4; ++j) { v[j] = xr[64 * j]; s += (v[j].x * v[j].x + v[j].y * v[j].y) + (v[j].z * v[j].z + v[j].w * v[j].w); }
        const float rstd = rsqrtf(wave_sum(s) * (1.f / DM) + EPS);
#pragma unroll
        for (int j = 0; j < 4; ++j) xr[64 * j] = v[j] * rstd * gp[64 * j];
    }
}

constexpr int G_LR = 0, G_WD = 8192, G_BD = 16384, G_PT = 16896, G_CUM = 18944;
constexpr int G_QK = 51712;
constexpr int G_VT = 88576;
constexpr int G_SC = 107008;
constexpr int G_SSQ = 116224;
constexpr int G_ST = 0;
constexpr int RS = 72;

struct CumIn { f32x4 lr; f32x4 wd; float bd; };
__device__ __forceinline__ CumIn gla_cum_load(const float* LRB, const float* w_decay, const float* b_decay, int row0, int h, int tid) {
    CumIn ci;
    { const int t = tid >> 3, part = tid & 7; ci.lr = *(const f32x4*)(LRB + (size_t)(row0 + t) * 32 + 4 * part); }
    { const int idx = tid * 4, dir = idx >> 10, j = (idx >> 6) & 15, d = idx & 63; ci.wd = *(const f32x4*)(w_decay + dir * 4096 + j * 256 + h * 64 + d); }
    ci.bd = b_decay[((tid >> 6) & 1) * 256 + h * 64 + (tid & 63)];
    return ci;
}
__device__ __forceinline__ void gla_cum_compute(LAS unsigned char* L, const CumIn& ci, int tid) {
    LAS float* LR = (LAS float*)(L + G_LR); LAS float* WD = (LAS float*)(L + G_WD); LAS float* BD = (LAS float*)(L + G_BD);
    LAS float* PT = (LAS float*)(L + G_PT); LAS float* CUM = (LAS float*)(L + G_CUM);
    { const int t = tid >> 3, part = tid & 7;
      LAS float* dst = LR + ((part >> 2) * 64 + t) * 16 + (part & 3) * 4;
      *(LAS f32x4*)dst = ci.lr; }
    *(LAS f32x4*)(WD + tid * 4) = ci.wd;
    if (tid < 128) BD[tid] = ci.bd;
    __syncthreads();
    const int d = tid & 63, dir = (tid >> 6) & 1, part = tid >> 7;
    {
        float wreg[16];
#pragma unroll
        for (int j = 0; j < 16; ++j) wreg[j] = WD[dir * 1024 + j * 64 + d];
        const float bias = BD[dir * 64 + d];
        float run = 0.f;
#pragma unroll
        for (int i = 0; i < 16; ++i) {
            const int t = dir == 0 ? part * 16 + i : part * 16 + 15 - i;
            const LAS f32x4* lr = (const LAS f32x4*)(LR + (dir * 64 + t) * 16);
            float x = bias;
#pragma unroll
            for (int j = 0; j < 4; ++j) { const f32x4 v = lr[j]; x += v[0] * wreg[4 * j] + v[1] * wreg[4 * j + 1] + v[2] * wreg[4 * j + 2] + v[3] * wreg[4 * j + 3]; }
            const float la = (fminf(x, 0.f) - __logf(1.f + __expf(-fabsf(x)))) * (1.f / 16.f);
            run += la; CUM[(dir * 64 + t) * 64 + d] = run;
        }
        PT[(dir * 4 + part) * 64 + d] = run;
    }
    __syncthreads();
    {
        float off = 0.f;
#pragma unroll
        for (int p = 0; p < 4; ++p) { const float v = PT[(dir * 4 + p) * 64 + d]; if (dir == 0 ? p < part : p > part) off += v; }
#pragma unroll
        for (int i = 0; i < 16; ++i) CUM[(dir * 64 + part * 16 + i) * 64 + d] += off;
    }
    __syncthreads();
}
struct VIn { v4u a, b; };
__device__ __forceinline__ VIn gla_v_load(const bf16* PROJ, int row0, int h, int tid) {
    const int s = tid >> 3, e0 = (tid & 7) * 16;
    const v4u* src = (const v4u*)(PROJ + (size_t)(row0 + s) * NINP + PC_V + h * 128 + e0);
    VIn v; v.a = src[0]; v.b = src[1]; return v;
}
__device__ __forceinline__ void gla_v_store(LAS unsigned char* L, const VIn& v, int tid) {
    LAS bf16* VT = (LAS bf16*)(L + G_VT);
    const int s = tid >> 3, e0 = (tid & 7) * 16;
    const unsigned w[8] = {v.a.x, v.a.y, v.a.z, v.a.w, v.b.x, v.b.y, v.b.z, v.b.w};
#pragma unroll
    for (int i = 0; i < 8; ++i) { VT[(e0 + 2 * i) * RS + s] = (bf16)(w[i] & 0xffffu); VT[(e0 + 2 * i + 1) * RS + s] = (bf16)(w[i] >> 16); }
}
#define MFMA16(a, b, c) __builtin_amdgcn_mfma_f32_16x16x32_bf16((a), (b), (c), 0, 0, 0)
#define LDFRAG(base, row, kk) (*(const LAS bf16x8*)((base) + (row) * RS + (kk) * 32 + fq * 8))

__device__ __forceinline__ void phase_lr(const bf16* H, const bf16* WLR, float* LRB, int tid) {
    const int wave = tid >> 6, lane = tid & 63, fr = lane & 15, fq = lane >> 4, mt = wave & 3, nt = wave >> 2;
    for (int rb = blockIdx.x; rb < NTOK / 64; rb += gridDim.x) {
        const bf16* ap = H + (size_t)(rb * 64 + mt * 16 + fr) * DM + 8 * fq;
        const bf16* bp = WLR + (size_t)(nt * 16 + fr) * DM + 8 * fq;
        f32x4 acc = {0.f, 0.f, 0.f, 0.f};
#pragma unroll
        for (int k = 0; k < DM; k += 32) acc = MFMA16(*(const bf16x8*)(bp + k), *(const bf16x8*)(ap + k), acc);
        *(f32x4*)(LRB + (size_t)(rb * 64 + mt * 16 + fr) * 32 + nt * 16 + 4 * fq) = acc;
    }
}
__device__ __forceinline__ void phase_gla_local(LAS unsigned char* L, const bf16* PROJ, const float* LRB, const float* w_decay, const float* b_decay, float* STATE, float* TOT, int tid) {
    const int wave = tid >> 6, lane = tid & 63, fr = lane & 15, fq = lane >> 4;
    LAS float* CUM = (LAS float*)(L + G_CUM); LAS bf16* KT = (LAS bf16*)(L + G_QK); LAS bf16* VT = (LAS bf16*)(L + G_VT);
    for (int unit = blockIdx.x; unit < 1024; unit += gridDim.x) {
        const int gc = unit >> 2, h = unit & 3, row0 = gc * 64;
        const CumIn ci = gla_cum_load(LRB, w_decay, b_decay, row0, h, tid);
        const int s = tid >> 3, d0 = (tid & 7) * 8;
        const v4u kr = *(const v4u*)(PROJ + (size_t)(row0 + s) * NINP + PC_K + h * 64 + d0);
        const VIn vin = gla_v_load(PROJ, row0, h, tid);
        gla_cum_compute(L, ci, tid);
        { const unsigned w[4] = {kr.x, kr.y, kr.z, kr.w};
#pragma unroll
          for (int i = 0; i < 8; ++i) {
              const int d = d0 + i; const float k = (i & 1) ? bfhi(w[i >> 1]) : bflo(w[i >> 1]);
              const float tf = CUM[(63) * 64 + d], tb = CUM[(64 + 0) * 64 + d];
              const float cf = CUM[s * 64 + d], cb = CUM[(64 + s) * 64 + d];
              const unsigned pf = pk2(k * __expf(tf - cf), 0.f), pb = pk2(k * __expf(tb - cb), 0.f);
              KT[(d) * RS + s] = (bf16)(pf & 0xffffu); KT[(64 + d) * RS + s] = (bf16)(pb & 0xffffu);
          } }
        gla_v_store(L, vin, tid);
        if (tid < 128) { const int dir = tid >> 6, d = tid & 63; TOT[(size_t)((gc * 4 + h) * 2 + dir) * 64 + d] = dir == 0 ? CUM[63 * 64 + d] : CUM[64 * 64 + d]; }
        __syncthreads();
        { const int dir = wave >> 2, dt = wave & 3;
          const bf16x8 q0 = LDFRAG(KT, dir * 64 + dt * 16 + fr, 0), q1 = LDFRAG(KT, dir * 64 + dt * 16 + fr, 1);
          float* dst = STATE + (size_t)((gc * 4 + h) * 2 + dir) * 8192 + (dt * 16 + fr) * 128 + 4 * fq;
#pragma unroll
          for (int i = 0; i < 8; ++i) {
              const bf16x8 p0 = LDFRAG(VT, i * 16 + fr, 0), p1 = LDFRAG(VT, i * 16 + fr, 1);
              f32x4 acc = {0.f, 0.f, 0.f, 0.f};
              acc = MFMA16(p0, q0, acc); acc = MFMA16(p1, q1, acc);
              *(f32x4*)(dst + i * 16) = acc;
          } }
        __syncthreads();
    }
}

__device__ __forceinline__ void scan_chain(int item, bool sample, float* STATE, const float* TOT, const float* state_in, float* new_state) {
    const int e4 = item & 31, d = (item >> 5) & 63, dir = (item >> 11) & 1, h = (item >> 12) & 3, seq = item >> 14;
    const int N = sample ? 32 : 4, gc0 = sample ? 128 + 32 * seq : 4 * seq;
    f32x4 S = {0.f, 0.f, 0.f, 0.f};
    const size_t sidx = (size_t)((seq * 2 + dir) * 4 + h) * 8192 + d * 128 + e4 * 4;
    if (sample) S = *(const f32x4*)(state_in + sidx);
    for (int st = 0; st < N; st += 4) {
        f32x4 loc[4]; float a[4]; float* p[4];
#pragma unroll
        for (int i = 0; i < 4; ++i) {
            const int c = dir == 0 ? st + i : N - 1 - (st + i); const size_t g = (size_t)((gc0 + c) * 4 + h) * 2 + dir;
            p[i] = STATE + g * 8192 + d * 128 + e4 * 4; loc[i] = *(const f32x4*)p[i]; a[i] = TOT[g * 64 + d];
        }
#pragma unroll
        for (int i = 0; i < 4; ++i) { *(f32x4*)p[i] = S; S = S * expf(a[i]) + loc[i]; }
    }
    if (!sample) *(f32x4*)(new_state + sidx) = S;
}
__device__ __forceinline__ void phase_scan(float* STATE, const float* TOT, const float* state_in, float* new_state, int gtid, int nthr) {
    for (int v = gtid; v < 131072; v += nthr) {
        if (v < 65536) { scan_chain(v, true, STATE, TOT, state_in, new_state); scan_chain(v, false, STATE, TOT, state_in, new_state); }
        else { for (int i = 0; i < 7; ++i) scan_chain(65536 + i * 65536 + (v - 65536), false, STATE, TOT, state_in, new_state); }
    }
}

__device__ __forceinline__ void phase_conv(const bf16* PROJ, const float* conv_w, bf16* MIX, int gtid, int nthr) {
#pragma unroll 2
    for (int item = gtid; item < NTOK * 64; item += nthr) {
        const int row = item >> 6, c = (item & 63) * 8;
        const bool sample = row >= NP; const int tl = sample ? (row & 63) : (row & 255), Lseg = sample ? 64 : 256;
        const bool hasp = tl > 0, hasn = tl < Lseg - 1;
        const bf16* prow = PROJ + (size_t)row * NINP;
        const v4u cbv = *(const v4u*)(prow + PC_CB + c);
        const v4u ccm = *(const v4u*)(prow + PC_CC + c), chm = *(const v4u*)(prow + PC_CH + c);
        v4u ccp = {0u, 0u, 0u, 0u}, chp = ccp, ccn = ccp, chn = ccp;
        if (hasp) { ccp = *(const v4u*)(prow - NINP + PC_CC + c); chp = *(const v4u*)(prow - NINP + PC_CH + c); }
        if (hasn) { ccn = *(const v4u*)(prow + NINP + PC_CC + c); chn = *(const v4u*)(prow + NINP + PC_CH + c); }
        const f32x4 w0l = *(const f32x4*)(conv_w + c), w0h = *(const f32x4*)(conv_w + c + 4);
        const f32x4 w1l = *(const f32x4*)(conv_w + 512 + c), w1h = *(const f32x4*)(conv_w + 512 + c + 4);
        const f32x4 w2l = *(const f32x4*)(conv_w + 1024 + c), w2h = *(const f32x4*)(conv_w + 1024 + c + 4);
        const float w0[8] = {w0l[0], w0l[1], w0l[2], w0l[3], w0h[0], w0h[1], w0h[2], w0h[3]};
        const float w1[8] = {w1l[0], w1l[1], w1l[2], w1l[3], w1h[0], w1h[1], w1h[2], w1h[3]};
        const float w2[8] = {w2l[0], w2l[1], w2l[2], w2l[3], w2h[0], w2h[1], w2h[2], w2h[3]};
        const unsigned cbw[4] = {cbv.x, cbv.y, cbv.z, cbv.w}, ccmw[4] = {ccm.x, ccm.y, ccm.z, ccm.w}, chmw[4] = {chm.x, chm.y, chm.z, chm.w};
        const unsigned ccpw[4] = {ccp.x, ccp.y, ccp.z, ccp.w}, chpw[4] = {chp.x, chp.y, chp.z, chp.w}, ccnw[4] = {ccn.x, ccn.y, ccn.z, ccn.w}, chnw[4] = {chn.x, chn.y, chn.z, chn.w};
        unsigned ow[4];
#pragma unroll
        for (int i = 0; i < 4; ++i) {
            const float lo = bflo(cbw[i]) * (w0[2 * i] * bflo(ccpw[i]) * bflo(chpw[i]) + w1[2 * i] * bflo(ccmw[i]) * bflo(chmw[i]) + w2[2 * i] * bflo(ccnw[i]) * bflo(chnw[i]));
            const float hi = bfhi(cbw[i]) * (w0[2 * i + 1] * bfhi(ccpw[i]) * bfhi(chpw[i]) + w1[2 * i + 1] * bfhi(ccmw[i]) * bfhi(chmw[i]) + w2[2 * i + 1] * bfhi(ccnw[i]) * bfhi(chnw[i]));
            ow[i] = pk2(lo, hi);
        }
        *(v4u*)(MIX + (size_t)row * DM + 512 + c) = (v4u){ow[0], ow[1], ow[2], ow[3]};
    }
}
__device__ __forceinline__ void phase_gla_out(LAS unsigned char* L, const bf16* PROJ, const float* LRB, const float* w_decay, const float* b_decay, const float* STATE,
                                              const float* gla_norm, bf16* MIX, int tid) {
    const int wave = tid >> 6, lane = tid & 63, fr = lane & 15, fq = lane >> 4;
    LAS float* CUM = (LAS float*)(L + G_CUM);
    LAS bf16* QF = (LAS bf16*)(L + G_QK); LAS bf16* KF = QF + 64 * RS; LAS bf16* QB = KF + 64 * RS; LAS bf16* KB = QB + 64 * RS;
    LAS bf16* VT = (LAS bf16*)(L + G_VT); LAS bf16* SC = (LAS bf16*)(L + G_SC); LAS float* SSQ = (LAS float*)(L + G_SSQ);
    LAS bf16* STF = (LAS bf16*)(L + G_ST); LAS bf16* STB = STF + 128 * RS;
    for (int unit = blockIdx.x; unit < 1024; unit += gridDim.x) {
        const int gc = unit >> 2, h = unit & 3, row0 = gc * 64;
        const int tt = wave & 3, eh = wave >> 2, t = tt * 16 + fr;
        const CumIn ci = gla_cum_load(LRB, w_decay, b_decay, row0, h, tid);
        const int s = tid >> 3, d0 = (tid & 7) * 8;
        const v4u qr = *(const v4u*)(PROJ + (size_t)(row0 + s) * NINP + PC_Q + h * 64 + d0);
        const v4u kr = *(const v4u*)(PROJ + (size_t)(row0 + s) * NINP + PC_K + h * 64 + d0);
        const VIn vin = gla_v_load(PROJ, row0, h, tid);
        f32x4 st0[2][2], st1[2][2];
#pragma unroll
        for (int dir = 0; dir < 2; ++dir) {
            const float* sp = STATE + (size_t)((gc * 4 + h) * 2 + dir) * 8192;
#pragma unroll
            for (int i = 0; i < 2; ++i) { const int idx = tid + 512 * i, d2 = idx >> 5, e4 = idx & 31;
                st0[dir][i] = *(const f32x4*)(sp + (2 * d2) * 128 + e4 * 4); st1[dir][i] = *(const f32x4*)(sp + (2 * d2 + 1) * 128 + e4 * 4); }
        }
        v2u gr[4];
        { const bf16* grow = PROJ + (size_t)(row0 + t) * NINP + PC_G + h * 128;
#pragma unroll
          for (int i4 = 0; i4 < 4; ++i4) gr[i4] = *(const v2u*)(grow + (eh * 4 + i4) * 16 + 4 * fq); }
        gla_cum_compute(L, ci, tid);
        { const unsigned qw[4] = {qr.x, qr.y, qr.z, qr.w}, kw[4] = {kr.x, kr.y, kr.z, kr.w};
          unsigned oqf[4], okf[4], oqb[4], okb[4];
#pragma unroll
          for (int i = 0; i < 4; ++i) {
              const int d = d0 + 2 * i;
              const float cf0 = CUM[s * 64 + d], cf1 = CUM[s * 64 + d + 1], cb0 = CUM[(64 + s) * 64 + d], cb1 = CUM[(64 + s) * 64 + d + 1];
              const float q0 = bflo(qw[i]) * 0.125f, q1 = bfhi(qw[i]) * 0.125f, k0 = bflo(kw[i]), k1 = bfhi(kw[i]);
              oqf[i] = pk2(q0 * __expf(cf0), q1 * __expf(cf1)); okf[i] = pk2(k0 * __expf(-cf0), k1 * __expf(-cf1));
              oqb[i] = pk2(q0 * __expf(cb0), q1 * __expf(cb1)); okb[i] = pk2(k0 * __expf(-cb0), k1 * __expf(-cb1));
          }
          *(LAS v4u*)(QF + s * RS + d0) = (v4u){oqf[0], oqf[1], oqf[2], oqf[3]}; *(LAS v4u*)(KF + s * RS + d0) = (v4u){okf[0], okf[1], okf[2], okf[3]};
          *(LAS v4u*)(QB + s * RS + d0) = (v4u){oqb[0], oqb[1], oqb[2], oqb[3]}; *(LAS v4u*)(KB + s * RS + d0) = (v4u){okb[0], okb[1], okb[2], okb[3]}; }
        gla_v_store(L, vin, tid);
        __syncthreads();
#pragma unroll
        for (int dir = 0; dir < 2; ++dir) {
            LAS bf16* ST = dir == 0 ? STF : STB;
#pragma unroll
            for (int i = 0; i < 2; ++i) {
                const int idx = tid + 512 * i, d2 = idx >> 5, e4 = idx & 31;
#pragma unroll
                for (int r = 0; r < 4; ++r) *(LAS unsigned*)(ST + (e4 * 4 + r) * RS + 2 * d2) = pk2(st0[dir][i][r], st1[dir][i][r]);
            }
        }
        { const bf16x8 qf0 = LDFRAG(QF, tt * 16 + fr, 0), qf1 = LDFRAG(QF, tt * 16 + fr, 1), qb0 = LDFRAG(QB, tt * 16 + fr, 0), qb1 = LDFRAG(QB, tt * 16 + fr, 1);
#pragma unroll
          for (int j = 0; j < 2; ++j) {
              const int st = (wave >> 2) * 2 + j;
              const bf16x8 kf0 = LDFRAG(KF, st * 16 + fr, 0), kf1 = LDFRAG(KF, st * 16 + fr, 1), kb0 = LDFRAG(KB, st * 16 + fr, 0), kb1 = LDFRAG(KB, st * 16 + fr, 1);
              f32x4 af = {0.f, 0.f, 0.f, 0.f}, ab = {0.f, 0.f, 0.f, 0.f};
              af = MFMA16(kf0, qf0, af); af = MFMA16(kf1, qf1, af);
              ab = MFMA16(kb0, qb0, ab); ab = MFMA16(kb1, qb1, ab);
              const int s0 = st * 16 + 4 * fq;
              float v[4];
#pragma unroll
              for (int r = 0; r < 4; ++r) { const int sx = s0 + r; v[r] = (sx <= t ? af[r] : 0.f) + (sx >= t ? ab[r] : 0.f); }
              *(LAS v2u*)(SC + t * RS + s0) = (v2u){pk2(v[0], v[1]), pk2(v[2], v[3])};
          } }
        __syncthreads();
        f32x4 o[4]; float ssq = 0.f;
        { const bf16x8 a0 = LDFRAG(SC, t, 0), a1 = LDFRAG(SC, t, 1), b0 = LDFRAG(QF, t, 0), b1 = LDFRAG(QF, t, 1), c0 = LDFRAG(QB, t, 0), c1 = LDFRAG(QB, t, 1);
#pragma unroll
          for (int i4 = 0; i4 < 4; ++i4) {
              const int er = (eh * 4 + i4) * 16 + fr;
              f32x4 acc = {0.f, 0.f, 0.f, 0.f};
              acc = MFMA16(LDFRAG(VT, er, 0), a0, acc); acc = MFMA16(LDFRAG(VT, er, 1), a1, acc);
              acc = MFMA16(LDFRAG(STF, er, 0), b0, acc); acc = MFMA16(LDFRAG(STF, er, 1), b1, acc);
              acc = MFMA16(LDFRAG(STB, er, 0), c0, acc); acc = MFMA16(LDFRAG(STB, er, 1), c1, acc);
              o[i4] = acc; ssq += (acc[0] * acc[0] + acc[1] * acc[1]) + (acc[2] * acc[2] + acc[3] * acc[3]);
          } }
        ssq += __shfl_xor(ssq, 16); ssq += __shfl_xor(ssq, 32);
        if (fq == 0) SSQ[eh * 64 + t] = ssq;
        __syncthreads();
        { const float rstd = rsqrtf((SSQ[t] + SSQ[64 + t]) * (1.f / 128.f) + EPS);
          bf16* orow = MIX + (size_t)(row0 + t) * DM + h * 128;
#pragma unroll
          for (int i4 = 0; i4 < 4; ++i4) {
              const int e = (eh * 4 + i4) * 16 + 4 * fq;
              const f32x4 gn = *(const f32x4*)(gla_norm + h * 128 + e);
              const float y0 = o[i4][0] * rstd * gn[0] * silu_f(bflo(gr[i4].x)), y1 = o[i4][1] * rstd * gn[1] * silu_f(bfhi(gr[i4].x));
              const float y2 = o[i4][2] * rstd * gn[2] * silu_f(bflo(gr[i4].y)), y3 = o[i4][3] * rstd * gn[3] * silu_f(bfhi(gr[i4].y));
              *(v2u*)(orow + e) = (v2u){pk2(y0, y1), pk2(y2, y3)};
          } }
        __syncthreads();
    }
}

#define XB_TMO      128
#define XB_XCNT(j)  (256  + 64 * (j))
#define XB_XSUB(j)  (1280 + 64 * (j))
#define XB_XGEN(j)  (2304 + 64 * (j))
#define XB_TOP      3328
#define XB_TOPGEN   3392
#define XCD_BAR_WORDS 3456
#define XB_SPIN_CAP (1u << 18)

__device__ __forceinline__ unsigned xb_ld(unsigned* p)              { return __hip_atomic_load(p, __ATOMIC_RELAXED, __HIP_MEMORY_SCOPE_AGENT); }
__device__ __forceinline__ unsigned xb_add(unsigned* p, unsigned v) { return __hip_atomic_fetch_add(p, v, __ATOMIC_RELAXED, __HIP_MEMORY_SCOPE_AGENT); }
__device__ __forceinline__ unsigned xb_xcc_id() { return (unsigned)__builtin_amdgcn_s_getreg((3 << 11) | 20) & 0xFu; }
#define XB_SPIN(cond, bar) do { unsigned _sp = 0; while (cond) { __builtin_amdgcn_s_sleep(1); \
    if ((++_sp & 255u) == 0u) { if (xb_ld(&(bar)[XB_TMO])) break; if (_sp > XB_SPIN_CAP) { atomicAdd(&(bar)[XB_TMO], 1u); break; } } } } while (0)

struct XcdBarrier {
    unsigned* bar; unsigned x;
    volatile LAS unsigned* st;
};

__device__ __forceinline__ XcdBarrier xcd_barrier_post(unsigned* bar, volatile LAS unsigned* st) {
    XcdBarrier b; b.bar = bar; b.x = xb_xcc_id(); b.st = st;
    if (threadIdx.x == 0) (void)xb_add(&bar[XB_XCNT(b.x)], 1u);
    return b;
}
__device__ __forceinline__ void xcd_barrier_complete(unsigned* bar, unsigned x, unsigned& nloc, unsigned& nx) {
    const unsigned G = gridDim.x * gridDim.y * gridDim.z;
    unsigned sum, cnt, mine, sp = 0u;
    for (;;) {
        sum = 0u; cnt = 0u; mine = 0u;
#pragma unroll
        for (unsigned j = 0; j < 16; ++j) { const unsigned c = xb_ld(&bar[XB_XCNT(j)]); sum += c; cnt += (c > 0u) ? 1u : 0u; mine = (j == x) ? c : mine; }
        if (sum == G) break;
        __builtin_amdgcn_s_sleep(1);
        if ((++sp & 255u) == 0u) { if (xb_ld(&bar[XB_TMO])) break; if (sp > XB_SPIN_CAP) { atomicAdd(&bar[XB_TMO], 1u); break; } }
    }
    nloc = mine > 0u ? mine : 1u; nx = cnt > 0u ? cnt : 1u;
}

__device__ __forceinline__ void xcd_barrier(const XcdBarrier& b) {
    asm volatile("s_waitcnt vmcnt(0)" ::: "memory");
    __syncthreads();
    if (threadIdx.x == 0) {
        unsigned* bar = b.bar;
        __builtin_amdgcn_s_waitcnt(0);
        unsigned nloc = b.st[0], nx = b.st[1];
        if (nloc == 0u) { xcd_barrier_complete(bar, b.x, nloc, nx); b.st[0] = nloc; b.st[1] = nx; }
        const unsigned old = xb_add(&bar[XB_XSUB(b.x)], 1u);
        const unsigned gen = old / nloc;
        if (old + 1u == (gen + 1u) * nloc) {
            __builtin_amdgcn_fence(__ATOMIC_RELEASE, "agent");
            asm volatile("s_waitcnt vmcnt(0)" ::: "memory");
            const unsigned og = xb_add(&bar[XB_TOP], 1u);
            const unsigned tg = og / nx;
            if (og + 1u == (tg + 1u) * nx) xb_add(&bar[XB_TOPGEN], 1u);
            else XB_SPIN(xb_ld(&bar[XB_TOPGEN]) == tg, bar);
            __builtin_amdgcn_fence(__ATOMIC_ACQUIRE, "agent");
            xb_add(&bar[XB_XGEN(b.x)], 1u);
            asm volatile("s_waitcnt vmcnt(0)" ::: "memory");
        } else {
            XB_SPIN(xb_ld(&bar[XB_XGEN(b.x)]) == gen, bar);
            __builtin_amdgcn_fence(__ATOMIC_ACQUIRE, "agent");
            asm volatile("s_waitcnt vmcnt(0)" ::: "memory");
        }
    }
    __syncthreads();
}
struct Args {
    const float *x_prompt, *x_sample, *state_gla, *c, *c_ctx, *w_ada, *b_ada, *norm_ffn1, *w1_ffn1, *w3_ffn1, *w2_ffn1, *norm_mix, *w_in, *w_decay, *b_decay,
                *gla_norm, *conv_w, *w_out, *norm_ffn2, *w1_ffn2, *w3_ffn2, *w2_ffn2, *final_norm;
    float* out; unsigned char* ws;
};

enum { I_XP = 0, I_XS, I_STATE, I_C, I_CCTX, I_WADA, I_BADA, I_NF1, I_W1A, I_W3A, I_W2A, I_NMIX, I_WIN, I_WDEC, I_BDEC, I_GNORM, I_CONVW, I_WOUT, I_NF2, I_W1B, I_W3B, I_W2B, I_FNORM, I_OUT, I_WS };
constexpr int LDS_XST = 140000, LDS_ARGS = 140032;
__device__ __forceinline__ unsigned long long ldarg(LAS unsigned char* L, int i) {
    const unsigned long long v = *(volatile LAS unsigned long long*)(L + LDS_ARGS + 8 * i);
    const unsigned lo = __builtin_amdgcn_readfirstlane((unsigned)v), hi = __builtin_amdgcn_readfirstlane((unsigned)(v >> 32));
    return ((unsigned long long)hi << 32) | lo;
}
#define ARGF(i) ((const float*)ldarg(L, (i)))
#define WSP() ((unsigned char*)ldarg(L, I_WS))
#define OUTP() ((float*)ldarg(L, I_OUT))
#undef GSYNC
#define GSYNC() do { for (int r_ = 0; r_ < REP_SYNC; ++r_) { XcdBarrier xb_; xb_.bar = (unsigned*)(WSP() + WS_BAR); xb_.x = xb_xcc_id(); xb_.st = (volatile LAS unsigned*)(L + LDS_XST); xcd_barrier(xb_); } } while (0)

__global__ void __launch_bounds__(512, 2) mega_fwd(Args A) {
    extern __shared__ __attribute__((aligned(16))) unsigned char lds_raw[];
    LAS unsigned char* L = (LAS unsigned char*)lds_raw;
    const int tid = threadIdx.x, lane = tid & 63, wave = __builtin_amdgcn_readfirstlane(tid >> 6);
    if (A.ws == nullptr) { cg::grid_group grid = cg::this_grid(); grid.sync(); }
    if (tid == 0) {
        LAS unsigned long long* LA = (LAS unsigned long long*)(L + LDS_ARGS);
        LA[I_XP] = (unsigned long long)A.x_prompt; LA[I_XS] = (unsigned long long)A.x_sample; LA[I_STATE] = (unsigned long long)A.state_gla; LA[I_C] = (unsigned long long)A.c;
        LA[I_CCTX] = (unsigned long long)A.c_ctx; LA[I_WADA] = (unsigned long long)A.w_ada; LA[I_BADA] = (unsigned long long)A.b_ada; LA[I_NF1] = (unsigned long long)A.norm_ffn1;
        LA[I_W1A] = (unsigned long long)A.w1_ffn1; LA[I_W3A] = (unsigned long long)A.w3_ffn1; LA[I_W2A] = (unsigned long long)A.w2_ffn1; LA[I_NMIX] = (unsigned long long)A.norm_mix;
        LA[I_WIN] = (unsigned long long)A.w_in; LA[I_WDEC] = (unsigned long long)A.w_decay; LA[I_BDEC] = (unsigned long long)A.b_decay; LA[I_GNORM] = (unsigned long long)A.gla_norm;
        LA[I_CONVW] = (unsigned long long)A.conv_w; LA[I_WOUT] = (unsigned long long)A.w_out; LA[I_NF2] = (unsigned long long)A.norm_ffn2; LA[I_W1B] = (unsigned long long)A.w1_ffn2;
        LA[I_W3B] = (unsigned long long)A.w3_ffn2; LA[I_W2B] = (unsigned long long)A.w2_ffn2; LA[I_FNORM] = (unsigned long long)A.final_norm; LA[I_OUT] = (unsigned long long)A.out;
        LA[I_WS] = (unsigned long long)A.ws;
    }
    if (tid < 2) ((volatile LAS unsigned*)(L + LDS_XST))[tid] = 0u;
    if (tid == 0) { ((volatile LAS unsigned long long*)(L + LDS_PROBE))[0] = 0ull; ((volatile LAS unsigned long long*)(L + LDS_PROBE))[1] = 0ull; }
    __syncthreads();
    (void)xcd_barrier_post((unsigned*)(WSP() + WS_BAR), (volatile LAS unsigned*)(L + LDS_XST));
#define GW (blockIdx.x * 8 + wave)
#define NGW_ (gridDim.x * 8)
#define GTID (blockIdx.x * 512 + tid)
#define NTHR (gridDim.x * 512)
#define P_MODS ((float*)(WSP() + WS_MODS))
#define P_H ((bf16*)(WSP() + WS_H))
#define P_PROJ ((bf16*)(WSP() + WS_PROJ))
#define P_STATE ((float*)(WSP() + WS_STATE))
#define P_TOT ((float*)(WSP() + WS_TOT))

    TB(0);
    for (int r_ = 0; r_ < REP_P0; ++r_) {
    phase_mods(L, ARGF(I_C), ARGF(I_CCTX), ARGF(I_WADA), ARGF(I_BADA), P_MODS, tid);
    { WPtrs W{ARGF(I_W1A), ARGF(I_W3A), ARGF(I_W2A), ARGF(I_WIN), ARGF(I_WOUT), ARGF(I_W1B), ARGF(I_W3B), ARGF(I_W2B)};
      phase_weights(L, W, WSP(), GW, NGW_, wave, lane); }
    __syncthreads(); }
    GSYNC();
    TE(0);
    TB(1);
    for (int r_ = 0; r_ < REP_NORM; ++r_) phase_normmod(ARGF(I_XP), ARGF(I_XS), ARGF(I_NF1), P_MODS, 0, 1, P_H, GW, NGW_, lane);
    GSYNC();
    TE(1);
    TB(2);
    for (int r_ = 0; r_ < REP_UP; ++r_) { unsigned char* ws = WSP(); pg8::Gemm g{(const bf16*)(ws + WS_H), (const bf16*)(ws + WS_WUP1), NTOK, 2 * DFF, DM}; pg8::StaticOrder S; S.init(NTOK, 2 * DFF, gridDim.x, (int)blockIdx.x);
      EpiSwiglu E{(bf16*)(ws + WS_PROJ), DFF}; pg8::gemm_phase<EpiSwiglu, pg8::StaticOrder, true, true>(L, g, S, E); }
    GSYNC();
    TE(2);
    TB(3);
    for (int r_ = 0; r_ < REP_DN; ++r_) { unsigned char* ws = WSP(); pg8::Gemm g{(const bf16*)(ws + WS_PROJ), (const bf16*)(ws + WS_WDN1), NTOK, DM, DFF}; pg8::StaticOrder S; S.init(NTOK, DM, gridDim.x, (int)blockIdx.x);
      EpiResid E{ARGF(I_XP), ARGF(I_XS), OUTP(), (const float*)(ws + WS_MODS), 2, 0.5f}; pg8::gemm_phase<EpiResid, pg8::StaticOrder, true, true>(L, g, S, E); }
    GSYNC();
    TE(3);
    TB(4);
    { float* RES = OUTP(); phase_normmod(RES, RES + (size_t)NP * DM, ARGF(I_NMIX), P_MODS, 3, 4, P_H, GW, NGW_, lane); }
    GSYNC();
    TE(4);
    TB(5);
    for (int r_ = 0; r_ < REP_IN; ++r_) { unsigned char* ws = WSP(); pg8::Gemm g{(const bf16*)(ws + WS_H), (const bf16*)(ws + WS_WIN), NTOK, NINP, DM}; pg8::StaticOrder S; S.init(NTOK, NINP, gridDim.x, (int)blockIdx.x);
      pg8::EpiBf16<0> E{(bf16*)(ws + WS_PROJ), NINP, nullptr, 0, 0, 1.f}; pg8::gemm_phase<pg8::EpiBf16<0>, pg8::StaticOrder, true, true>(L, g, S, E);
      phase_lr((const bf16*)(ws + WS_H), (const bf16*)(ws + WS_WLR), (float*)(ws + WS_LR), tid); }
    GSYNC();
    TE(5);
    TB(6);
    for (int r_ = 0; r_ < REP_GLA; ++r_) phase_gla_local(L, P_PROJ, (const float*)(WSP() + WS_LR), ARGF(I_WDEC), ARGF(I_BDEC), P_STATE, P_TOT, tid);
    GSYNC();
    TE(6);
    TB(7);
    phase_scan(P_STATE, P_TOT, ARGF(I_STATE), OUTP() + (size_t)NTOK * DM, GTID, NTHR);
    GSYNC();
    TE(7);
    TB(8);
    for (int r_ = 0; r_ < REP_GLA; ++r_) { phase_conv(P_PROJ, ARGF(I_CONVW), P_H, GTID, NTHR); phase_gla_out(L, P_PROJ, (const float*)(WSP() + WS_LR), ARGF(I_WDEC), ARGF(I_BDEC), P_STATE, ARGF(I_GNORM), P_H, tid); }
    GSYNC();
    TE(8);
    TB(9);
    { unsigned char* ws = WSP(); float* RES = OUTP(); pg8::Gemm g{(const bf16*)(ws + WS_H), (const bf16*)(ws + WS_WOUT), NTOK, DM, DM}; pg8::StaticOrder S; S.init(NTOK, DM, gridDim.x, (int)blockIdx.x);
      EpiResid E{RES, RES + (size_t)NP * DM, RES, (const float*)(ws + WS_MODS), 5, 1.0f}; pg8::gemm_phase<EpiResid, pg8::StaticOrder, true, true>(L, g, S, E); }
    GSYNC();
    TE(9);
    TB(10);
    { float* RES = OUTP(); phase_normmod(RES, RES + (size_t)NP * DM, ARGF(I_NF2), P_MODS, 6, 7, P_H, GW, NGW_, lane); }
    GSYNC();
    TE(10);
    TB(11);
    { unsigned char* ws = WSP(); pg8::Gemm g{(const bf16*)(ws + WS_H), (const bf16*)(ws + WS_WUP2), NTOK, 2 * DFF, DM}; pg8::StaticOrder S; S.init(NTOK, 2 * DFF, gridDim.x, (int)blockIdx.x);
      EpiSwiglu E{(bf16*)(ws + WS_PROJ), DFF}; pg8::gemm_phase<EpiSwiglu, pg8::StaticOrder, true, true>(L, g, S, E); }
    GSYNC();
    TE(11);
    TB(12);
    { unsigned char* ws = WSP(); float* RES = OUTP(); pg8::Gemm g{(const bf16*)(ws + WS_PROJ), (const bf16*)(ws + WS_WDN2), NTOK, DM, DFF}; pg8::StaticOrder S; S.init(NTOK, DM, gridDim.x, (int)blockIdx.x);
      EpiResid E{RES, RES + (size_t)NP * DM, RES, (const float*)(ws + WS_MODS), 8, 0.5f}; pg8::gemm_phase<EpiResid, pg8::StaticOrder, true, true>(L, g, S, E); }
    GSYNC();
    TE(12);
    TB(13);
    phase_final_norm(OUTP(), ARGF(I_FNORM), GW, NGW_, lane);
    TE(13);
    if (PROBE_MASK != 0 && blockIdx.x == 0 && tid == 0) {
        const unsigned long long acc_ = *(volatile LAS unsigned long long*)(L + LDS_PROBE), t0_ = __builtin_amdgcn_s_memrealtime();
        while (__builtin_amdgcn_s_memrealtime() - t0_ < (unsigned long long)PROBE_K * acc_) __builtin_amdgcn_s_sleep(8);
    }
}

extern "C" void kernel_launch(void* const* d_in, const int* in_sizes, int n_in, void* d_out, int out_size, void* d_ws, size_t ws_size, hipStream_t stream) {
    static int grid = 0;
    if (grid == 0) {
        if (n_in != 23 || ws_size < WS_END) { fprintf(stderr, "kernel_launch: unexpected n_in %d / ws %zu\n", n_in, ws_size); grid = -1; return; }
        int dev = 0, cus = 0, per_cu = 0;
        hipGetDevice(&dev);
        hipDeviceGetAttribute(&cus, hipDeviceAttributeMultiprocessorCount, dev);
        if (hipFuncSetAttribute((const void*)mega_fwd, hipFuncAttributeMaxDynamicSharedMemorySize, LDS_BYTES) != hipSuccess) { fprintf(stderr, "kernel_launch: hipFuncSetAttribute failed\n"); grid = -1; return; }
        hipOccupancyMaxActiveBlocksPerMultiprocessor(&per_cu, (const void*)mega_fwd, 512, LDS_BYTES);
        if (per_cu < 1) per_cu = 1;
        (void)hipGetLastError();
        grid = cus;
        if (grid > 256) grid = 256;
    }
    if (grid < 0) return;
    Args a{};
    const float** p = (const float**)&a;
    for (int i = 0; i < 23; ++i) p[i] = (const float*)d_in[i];
    a.out = (float*)d_out; a.ws = (unsigned char*)d_ws;
    (void)hipMemsetAsync((char*)d_ws + WS_BAR, 0, XCD_BAR_WORDS * 4, stream);
    void* args[] = {&a};
    hipError_t e = hipLaunchCooperativeKernel((const void*)mega_fwd, dim3(grid), dim3(512), args, LDS_BYTES, stream);
    if (e != hipSuccess) fprintf(stderr, "cooperative launch failed: %s (grid %d)\n", hipGetErrorString(e), grid);
}
```
